# Optimizing an MI355X kernel written in HIP

```python
import jax, jax.numpy as jnp
from jax import lax
import numpy as np

D_MODEL = 1024
BATCH = 2
SEQ = 8192
DEPTH = 2

D_MIX = D_MODEL
CONV_WIDTH = D_MIX // 4
CONV_GROUPS = 4
CONV_K = 31
MLA_HEADS = 8
MLA_NOPE = 64
MLA_ROPE = 32
MLA_QK = MLA_NOPE + MLA_ROPE
MLA_V = 64
MLA_WIDTH = MLA_HEADS * MLA_V
Q_LORA = 768
KV_LORA = 256
ROPE_THETA = 10000.0
Q_BLOCK = 128
SG_WIDTH = D_MIX - CONV_WIDTH - MLA_WIDTH
SG_HEADS = 4
SG_HEAD_DIM = SG_WIDTH // SG_HEADS
SG_CHUNK = 128
IN_SIZES = (CONV_WIDTH, CONV_WIDTH, CONV_WIDTH,
            Q_LORA, KV_LORA, MLA_ROPE, MLA_WIDTH,
            SG_WIDTH, SG_WIDTH, SG_WIDTH)
IN_COLS = 3 * CONV_WIDTH + Q_LORA + KV_LORA + MLA_ROPE + MLA_WIDTH + 3 * SG_WIDTH
EPS = 1e-6

kernel_name = 'hybrid_conv_mla_sgu_parallel_heads'


def _rms_norm(x, g):
    xf = x.astype(jnp.float32)
    y = xf * lax.rsqrt(jnp.mean(xf * xf, axis=-1, keepdims=True) + EPS)
    return (y * g.astype(jnp.float32)).astype(x.dtype)


def _layer_norm(x, g, b):
    xf = x.astype(jnp.float32)
    mu = jnp.mean(xf, axis=-1, keepdims=True)
    var = jnp.mean(jnp.square(xf - mu), axis=-1, keepdims=True)
    y = (xf - mu) * lax.rsqrt(var + EPS) * g.astype(jnp.float32) + b.astype(jnp.float32)
    return y.astype(x.dtype)


def _rope_tables(seq):
    half = MLA_ROPE // 2
    inv_freq = ROPE_THETA ** (-jnp.arange(half, dtype=jnp.float32) / half)
    ang = jnp.arange(seq, dtype=jnp.float32)[:, None] * inv_freq[None, :]
    return jnp.cos(ang), jnp.sin(ang)


def _apply_rope(x, cos, sin):
    half = MLA_ROPE // 2
    c = cos[None, :, None, :].astype(x.dtype)
    s = sin[None, :, None, :].astype(x.dtype)
    x1, x2 = x[..., :half], x[..., half:]
    return jnp.concatenate([x1 * c - x2 * s, x1 * s + x2 * c], axis=-1)


def _conv_branch(a, a_glu, conv_w, conv_b, ln_g, ln_b, pw_w, pw_b):
    y = a * jax.nn.sigmoid(a_glu)
    y = lax.conv_general_dilated(
        y, conv_w[:, None, :], window_strides=(1,),
        padding=[(CONV_K - 1, 0)],
        dimension_numbers=('NWC', 'WIO', 'NWC'),
        feature_group_count=CONV_WIDTH) + conv_b
    y = jax.nn.silu(_layer_norm(y, ln_g, ln_b))
    return y @ pw_w + pw_b


def _causal_attention(q, k, v):
    B, S, H, Dq = q.shape
    nb = S // Q_BLOCK
    scale = Dq ** -0.5
    q_blocks = jnp.moveaxis(q.reshape(B, nb, Q_BLOCK, H, Dq), 1, 0)
    k_pos = jnp.arange(S)

    def block(args):
        qb, i = args
        q_pos = i * Q_BLOCK + jnp.arange(Q_BLOCK)
        s = jnp.einsum('bqhd,bkhd->bhqk', qb, k).astype(jnp.float32) * scale
        s = jnp.where(k_pos[None, :] <= q_pos[:, None], s, -jnp.inf)
        p = jax.nn.softmax(s, axis=-1).astype(v.dtype)
        return jnp.einsum('bhqk,bkhd->bqhd', p, v)

    out = lax.map(block, (q_blocks, jnp.arange(nb)))
    return jnp.moveaxis(out, 0, 1).reshape(B, S, H * v.shape[-1])


def _mla_branch(c_q, c_kv, k_rope, q_norm_g, w_uq, kv_norm_g, w_ukv,
                qk_q_g, qk_k_g, cos, sin):
    B, S, _ = c_q.shape
    q = (_rms_norm(c_q, q_norm_g) @ w_uq).reshape(B, S, MLA_HEADS, MLA_QK)
    kv = (_rms_norm(c_kv, kv_norm_g) @ w_ukv).reshape(B, S, MLA_HEADS, MLA_NOPE + MLA_V)
    k_nope, v = kv[..., :MLA_NOPE], kv[..., MLA_NOPE:]
    k_r = jnp.broadcast_to(k_rope[:, :, None, :], (B, S, MLA_HEADS, MLA_ROPE))
    k = jnp.concatenate([k_nope, k_r], axis=-1)
    q = _rms_norm(q, qk_q_g)
    k = _rms_norm(k, qk_k_g)
    q = jnp.concatenate([q[..., :MLA_NOPE], _apply_rope(q[..., MLA_NOPE:], cos, sin)], axis=-1)
    k = jnp.concatenate([k[..., :MLA_NOPE], _apply_rope(k[..., MLA_NOPE:], cos, sin)], axis=-1)
    return _causal_attention(q, k, v)


def _sgu_branch(u, v, ln_g, ln_b, sg_w, sg_b):
    B, S, _ = u.shape
    nc = S // SG_CHUNK
    u = jax.nn.gelu(u)
    v = _layer_norm(jax.nn.gelu(v), ln_g, ln_b)
    v = v.reshape(B, nc, SG_CHUNK, SG_HEADS, SG_HEAD_DIM)
    mask = jnp.tril(jnp.ones((SG_CHUNK, SG_CHUNK), dtype=bool))
    w = jnp.where(mask[None], sg_w, jnp.zeros_like(sg_w))
    mixed = jnp.einsum('gts,bcsgd->bctgd', w, v) + sg_b.T[None, None, :, :, None]
    return u * mixed.reshape(B, S, SG_WIDTH)


def _layer(x, cos, sin, norm_g, w_in, conv_w, conv_b, conv_ln_g, conv_ln_b,
           conv_pw_w, conv_pw_b, q_norm_g, w_uq, kv_norm_g, w_ukv, qk_q_g, qk_k_g,
           sg_ln_g, sg_ln_b, sg_w, sg_b, branch_norm_g, w_out):
    h = _rms_norm(x, norm_g)
    proj = h @ w_in
    idx = np.cumsum(IN_SIZES)[:-1].tolist()
    (a, a_glu, z_conv, c_q, c_kv, k_rope, z_mla,
     u_sg, v_sg, z_sg) = jnp.split(proj, idx, axis=-1)

    y_conv = _conv_branch(a, a_glu, conv_w, conv_b, conv_ln_g, conv_ln_b,
                          conv_pw_w, conv_pw_b) * jax.nn.silu(z_conv)
    y_mla = _mla_branch(c_q, c_kv, k_rope, q_norm_g, w_uq, kv_norm_g, w_ukv,
                        qk_q_g, qk_k_g, cos, sin) * jax.nn.silu(z_mla)
    y_sg = _sgu_branch(u_sg, v_sg, sg_ln_g, sg_ln_b, sg_w, sg_b) * jax.nn.silu(z_sg)

    g_conv = branch_norm_g[:CONV_WIDTH]
    g_mla = branch_norm_g[CONV_WIDTH:CONV_WIDTH + MLA_WIDTH]
    g_sg = branch_norm_g[CONV_WIDTH + MLA_WIDTH:]
    y = jnp.concatenate([_rms_norm(y_conv, g_conv),
                         _rms_norm(y_mla, g_mla),
                         _rms_norm(y_sg, g_sg)], axis=-1)
    return x + y @ w_out


def setup_inputs(seed: int = 0) -> dict:
    key = jax.random.key(seed)
    ks = jax.random.split(key, 24)
    f32 = jnp.float32

    def nrm(k, shape, scale):
        return jax.random.normal(k, shape, f32) * scale

    def gain(k, shape):
        return 1.0 + 0.02 * jax.random.normal(k, shape, f32)

    L = DEPTH
    return {
        'x': jax.random.normal(ks[0], (BATCH, SEQ, D_MODEL), f32),
        'norm_g': gain(ks[1], (L, D_MODEL)),
        'w_in': nrm(ks[2], (L, D_MODEL, IN_COLS), D_MODEL ** -0.5),
        'conv_w': nrm(ks[3], (L, CONV_K, CONV_WIDTH), CONV_K ** -0.5),
        'conv_b': nrm(ks[4], (L, CONV_WIDTH), 0.01),
        'conv_ln_g': gain(ks[5], (L, CONV_WIDTH)),
        'conv_ln_b': nrm(ks[6], (L, CONV_WIDTH), 0.01),
        'conv_pw_w': nrm(ks[7], (L, CONV_WIDTH, CONV_WIDTH), CONV_WIDTH ** -0.5),
        'conv_pw_b': nrm(ks[8], (L, CONV_WIDTH), 0.01),
        'q_norm_g': gain(ks[9], (L, Q_LORA)),
        'w_uq': nrm(ks[10], (L, Q_LORA, MLA_HEADS * MLA_QK), Q_LORA ** -0.5),
        'kv_norm_g': gain(ks[11], (L, KV_LORA)),
        'w_ukv': nrm(ks[12], (L, KV_LORA, MLA_HEADS * (MLA_NOPE + MLA_V)), KV_LORA ** -0.5),
        'qk_q_g': gain(ks[13], (L, MLA_QK)),
        'qk_k_g': gain(ks[14], (L, MLA_QK)),
        'sg_ln_g': gain(ks[15], (L, SG_WIDTH)),
        'sg_ln_b': nrm(ks[16], (L, SG_WIDTH), 0.01),
        'sg_w': nrm(ks[17], (L, SG_HEADS, SG_CHUNK, SG_CHUNK), SG_CHUNK ** -0.5),
        'sg_b': 1.0 + nrm(ks[18], (L, SG_HEADS, SG_CHUNK), 0.1),
        'branch_norm_g': gain(ks[19], (L, D_MIX)),
        'w_out': nrm(ks[20], (L, D_MIX, D_MODEL), D_MIX ** -0.5),
    }


def reference(x, norm_g, w_in, conv_w, conv_b, conv_ln_g, conv_ln_b, conv_pw_w,
              conv_pw_b, q_norm_g, w_uq, kv_norm_g, w_ukv, qk_q_g, qk_k_g,
              sg_ln_g, sg_ln_b, sg_w, sg_b, branch_norm_g, w_out):
    cos, sin = _rope_tables(x.shape[1])
    for l in range(DEPTH):
        x = _layer(x, cos, sin, norm_g[l], w_in[l], conv_w[l], conv_b[l],
                   conv_ln_g[l], conv_ln_b[l], conv_pw_w[l], conv_pw_b[l],
                   q_norm_g[l], w_uq[l], kv_norm_g[l], w_ukv[l], qk_q_g[l], qk_k_g[l],
                   sg_ln_g[l], sg_ln_b[l], sg_w[l], sg_b[l], branch_norm_g[l], w_out[l])
    return x
```

```cpp
#include <hip/hip_runtime.h>
#include <hip/hip_cooperative_groups.h>
#include <cstdio>
#include <cmath>
namespace cg = cooperative_groups;

#ifndef MK_LAUNCHES
#define MK_LAUNCHES 1
#endif

typedef unsigned short bf16_t;
typedef short bf16x8 __attribute__((ext_vector_type(8)));
typedef float f32x16 __attribute__((ext_vector_type(16)));
typedef float f32x4 __attribute__((ext_vector_type(4)));
typedef float f32x2 __attribute__((ext_vector_type(2)));
typedef __bf16 bf2_t __attribute__((ext_vector_type(2)));
typedef unsigned u32x4 __attribute__((ext_vector_type(4)));
typedef unsigned u32x2 __attribute__((ext_vector_type(2)));
#define DI __device__ __forceinline__

constexpr int NT = 16384, SEQ = 8192, NIN = 3104;
constexpr int C_A = 0, C_AG = 256, C_ZC = 512, C_CQ = 768, C_CKV = 1536, C_ZM = 1792, C_U = 2304, C_V = 2560, C_ZS = 2816, C_KR = 3072;
constexpr int LROW = 144;
constexpr int LDS_BYTES = 69632;
constexpr float EPS = 1e-6f;

struct Params {
    const float* x; const float* norm_g; const float* w_in; const float* conv_w; const float* conv_b;
    const float* conv_ln_g; const float* conv_ln_b; const float* conv_pw_w; const float* conv_pw_b;
    const float* q_norm_g; const float* w_uq; const float* kv_norm_g; const float* w_ukv;
    const float* qk_q_g; const float* qk_k_g; const float* sg_ln_g; const float* sg_ln_b;
    const float* sg_w; const float* sg_b; const float* branch_norm_g; const float* w_out;
    float* out;
    bf16_t* proj; bf16_t* xb; bf16_t* Q; bf16_t* K; bf16_t* VT; bf16_t* Y;
    bf16_t* WinT; bf16_t* WuqT; bf16_t* WukvT; bf16_t* PwT; bf16_t* WoutT; bf16_t* SgW;
    float* ss_x; float* ss_p; float* ss_m; float* ss_s; float* rope;
    float invf[16];
    unsigned* bar; unsigned long long pad_;
};

DI unsigned pk(float lo, float hi) { f32x2 v = {lo, hi}; return __builtin_bit_cast(unsigned, __builtin_convertvector(v, bf2_t)); }
DI float bflo(unsigned w) { return __uint_as_float(w << 16); }
DI float bfhi(unsigned w) { return __uint_as_float(w & 0xffff0000u); }
DI float fexp2(float x) { return __builtin_amdgcn_exp2f(x); }
DI float rcpf_(float x) { return __builtin_amdgcn_rcpf(x); }
DI float sigmoidf_(float x) { return rcpf_(1.0f + __expf(-x)); }
DI float siluf_(float x) { return x * rcpf_(1.0f + __expf(-x)); }
DI float geluf_(float x) { const float u = 0.7978845608028654f * (x + 0.044715f * x * x * x); return x * rcpf_(1.0f + __expf(-2.0f * u)); }
DI unsigned opaque0() { unsigned z = 0; asm volatile("" : "+v"(z)); return z; }
DI int otid() { return (int)(threadIdx.x + opaque0()); }
DI int crow(int reg, int h) { return (reg & 3) + 8 * (reg >> 2) + 4 * h; }
DI f32x16 mfma(bf16x8 a, bf16x8 b, f32x16 c) { return __builtin_amdgcn_mfma_f32_32x32x16_bf16(a, b, c, 0, 0, 0); }
DI float sum8(const float* p) { const f32x4 a = *(const f32x4*)p, b = *(const f32x4*)(p + 4); return (a.x + a.y) + (a.z + a.w) + (b.x + b.y) + (b.z + b.w); }

template <int NFB, int NTB>
DI void gemm_tile(const bf16_t* __restrict__ Wp, int ldw, const bf16_t* __restrict__ Tp, int ldt, int K, char* lds, f32x16 (&acc)[NFB][NTB]) {
    constexpr int WROWS = NFB * 32, WCH = NFB, TCH = NTB * 4;
    char* ldsW = lds; char* ldsT = lds + WROWS * LROW;
    const int tid = otid(), lane = tid & 63, wave = tid >> 6, l31 = lane & 31, hh = lane >> 5;
    const int cr = tid >> 3, ckc = tid & 7;
    u32x4 wreg[WCH], treg[TCH];
    const bf16_t* wsrc = Wp + (size_t)cr * ldw + ckc * 8;
    const bf16_t* tsrc = Tp + (size_t)cr * ldt + ckc * 8;
#pragma unroll
    for (int i = 0; i < WCH; ++i) wreg[i] = *(const u32x4*)(wsrc + (size_t)(32 * i) * ldw);
#pragma unroll
    for (int i = 0; i < TCH; ++i) treg[i] = *(const u32x4*)(tsrc + (size_t)(32 * i) * ldt);
    const int nk = K >> 6;
    char* wdst = ldsW + cr * LROW + ckc * 16;
    char* tdst = ldsT + cr * LROW + ckc * 16;
    const char* wfp = ldsW + l31 * LROW + hh * 16;
    const char* tfp = ldsT + (wave * NTB * 32 + l31) * LROW + hh * 16;
    for (int kt = 0; kt < nk; ++kt) {
        __syncthreads();
#pragma unroll
        for (int i = 0; i < WCH; ++i) *(u32x4*)(wdst + 32 * i * LROW) = wreg[i];
#pragma unroll
        for (int i = 0; i < TCH; ++i) *(u32x4*)(tdst + 32 * i * LROW) = treg[i];
        __syncthreads();
        if (kt + 1 < nk) {
            const int ko = (kt + 1) * 64;
#pragma unroll
            for (int i = 0; i < WCH; ++i) wreg[i] = *(const u32x4*)(wsrc + (size_t)(32 * i) * ldw + ko);
#pragma unroll
            for (int i = 0; i < TCH; ++i) treg[i] = *(const u32x4*)(tsrc + (size_t)(32 * i) * ldt + ko);
        }
#pragma unroll
        for (int s = 0; s < 4; ++s) {
            bf16x8 wf[NFB], tf[NTB];
#pragma unroll
            for (int fb = 0; fb < NFB; ++fb) wf[fb] = *(const bf16x8*)(wfp + fb * 32 * LROW + s * 32);
#pragma unroll
            for (int tb = 0; tb < NTB; ++tb) tf[tb] = *(const bf16x8*)(tfp + tb * 32 * LROW + s * 32);
#pragma unroll
            for (int fb = 0; fb < NFB; ++fb)
#pragma unroll
                for (int tb = 0; tb < NTB; ++tb) acc[fb][tb] = mfma(wf[fb], tf[tb], acc[fb][tb]);
        }
    }
}

template <int NFB, int NTB> DI void zero_acc(f32x16 (&acc)[NFB][NTB]) {
#pragma unroll
    for (int a = 0; a < NFB; ++a)
#pragma unroll
        for (int b = 0; b < NTB; ++b)
#pragma unroll
            for (int r = 0; r < 16; ++r) acc[a][b][r] = 0.f;
}

DI void tconv_tile(const float* __restrict__ src, int ldsrc, int ks, int ns, int nvalid, const float* __restrict__ scale,
                   bf16_t* __restrict__ dst, int lddst, int kd, int nd, float* tile) {
    const int tid = threadIdx.x;
    __syncthreads();
    {
        const int n = tid & 63, kk = tid >> 6;
        float v[16];
#pragma unroll
        for (int r = 0; r < 16; ++r) v[r] = (n < nvalid) ? src[(size_t)(ks + r * 4 + kk) * ldsrc + ns + n] : 0.f;
        if (scale) {
#pragma unroll
            for (int r = 0; r < 16; ++r) v[r] *= scale[ks + r * 4 + kk];
        }
#pragma unroll
        for (int r = 0; r < 16; ++r) tile[(r * 4 + kk) * 65 + n] = v[r];
    }
    __syncthreads();
    {
        const int n = tid >> 2, kq = tid & 3;
        if (n < nvalid) {
            const float* tp = tile + (kq * 16) * 65 + n;
            u32x4 a, b;
            a.x = pk(tp[0 * 65], tp[1 * 65]);  a.y = pk(tp[2 * 65], tp[3 * 65]);   a.z = pk(tp[4 * 65], tp[5 * 65]);   a.w = pk(tp[6 * 65], tp[7 * 65]);
            b.x = pk(tp[8 * 65], tp[9 * 65]);  b.y = pk(tp[10 * 65], tp[11 * 65]); b.z = pk(tp[12 * 65], tp[13 * 65]); b.w = pk(tp[14 * 65], tp[15 * 65]);
            bf16_t* d = dst + (size_t)(nd + n) * lddst + kd + kq * 16;
            *(u32x4*)d = a; *(u32x4*)(d + 8) = b;
        }
    }
}

DI void phase0(const Params& p, char* lds) {
    float* tile = (float*)lds;
    const int tid = threadIdx.x, lane = tid & 63, wave = tid >> 6;
    for (int item = blockIdx.x; item < 2 * 1264; item += gridDim.x) {
        const int layer = item / 1264; int id = item % 1264;
        if (id < 784) {
            const int kt = id & 15, nt = id >> 4, nd = nt * 64;
            int ns, nv = 64;
            if (nd < 1792) ns = nd; else if (nd < 3072) ns = nd + 32; else { ns = 1792; nv = 32; }
            tconv_tile(p.w_in + (size_t)layer * 1024 * 3104, 3104, kt * 64, ns, nv, p.norm_g + layer * 1024,
                       p.WinT + (size_t)layer * 3104 * 1024, 1024, kt * 64, nd, tile);
        } else if ((id -= 784) < 144) {
            const int kt = id % 12, nt = id / 12;
            tconv_tile(p.w_uq + (size_t)layer * 768 * 768, 768, kt * 64, nt * 64, 64, p.q_norm_g + layer * 768,
                       p.WuqT + (size_t)layer * 768 * 768, 768, kt * 64, nt * 64, tile);
        } else if ((id -= 144) < 64) {
            const int kt = id & 3, nt = id >> 2;
            tconv_tile(p.w_ukv + (size_t)layer * 256 * 1024, 1024, kt * 64, nt * 64, 64, p.kv_norm_g + layer * 256,
                       p.WukvT + (size_t)layer * 1024 * 256, 256, kt * 64, nt * 64, tile);
        } else if ((id -= 64) < 16) {
            const int kt = id & 3, nt = id >> 2;
            tconv_tile(p.conv_pw_w + (size_t)layer * 256 * 256, 256, kt * 64, nt * 64, 64, nullptr,
                       p.PwT + (size_t)layer * 256 * 256, 256, kt * 64, nt * 64, tile);
        } else {
            id -= 16;
            const int kt = id & 15, nt = id >> 4, kd = kt * 64;
            const int ks = kd < 768 ? kd + 256 : kd - 768;
            tconv_tile(p.w_out + (size_t)layer * 1024 * 1024, 1024, ks, nt * 64, 64, p.branch_norm_g + layer * 1024,
                       p.WoutT + (size_t)layer * 1024 * 1024, 1024, kd, nt * 64, tile);
        }
    }
    const int gtid = blockIdx.x * 256 + tid, nthr = gridDim.x * 256;
    for (int e = gtid; e < 2 * 4 * 128 * 128; e += nthr) {
        const int t = (e >> 7) & 127, s = e & 127;
        p.SgW[e] = (bf16_t)(s <= t ? (pk(p.sg_w[e], 0.f) & 0xffffu) : 0u);
    }
    for (int e = gtid; e < SEQ * 16; e += nthr) {
        const int pos = e >> 4, i = e & 15;
        const float ang = (float)pos * p.invf[i];
        const double rev = (double)ang * 0.15915494309189535;
        const float fr = (float)(rev - floor(rev));
        p.rope[pos * 32 + i] = __builtin_amdgcn_cosf(fr);
        p.rope[pos * 32 + 16 + i] = __builtin_amdgcn_sinf(fr);
    }
    for (int row = (blockIdx.x * 4 + wave) * 2; row < NT; row += gridDim.x * 8) {
        f32x4 v[2][4];
#pragma unroll
        for (int rr = 0; rr < 2; ++rr)
#pragma unroll
            for (int i = 0; i < 4; ++i) v[rr][i] = ((const f32x4*)(p.x + (size_t)(row + rr) * 1024))[lane + 64 * i];
#pragma unroll
        for (int rr = 0; rr < 2; ++rr)
#pragma unroll
            for (int i = 0; i < 4; ++i) {
                const f32x4 a = v[rr][i];
                float ss = a.x * a.x + a.y * a.y + a.z * a.z + a.w * a.w;
                u32x2 w; w.x = pk(a.x, a.y); w.y = pk(a.z, a.w);
                *(u32x2*)(p.xb + (size_t)(row + rr) * 1024 + 4 * (lane + 64 * i)) = w;
                ss += __shfl_xor(ss, 16); ss += __shfl_xor(ss, 8); ss += __shfl_xor(ss, 4); ss += __shfl_xor(ss, 2); ss += __shfl_xor(ss, 1);
                if ((lane & 31) == 0) p.ss_x[(row + rr) * 8 + 2 * i + (lane >> 5)] = ss;
            }
    }
}

template <int NFB>
DI void epi_inproj(const Params& p, f32x16 (&acc)[NFB][2], int tok0, int col0, int ssslot, char* lds) {
    __builtin_amdgcn_sched_barrier(0);
    const int lane = otid() & 63, wave = otid() >> 6, l31 = lane & 31, hh = lane >> 5;
    constexpr int RB = NFB * 64 + 16;
    constexpr int CH = NFB * 4;
    constexpr int RPP = 64 / CH;
    char* wl = lds + wave * (32 * RB);
    __syncthreads();
#pragma unroll
    for (int tb = 0; tb < 2; ++tb) {
        const int tw = tok0 + wave * 64 + tb * 32;
        const int t = tw + l31;
        const float r = rsqrtf(sum8(p.ss_x + t * 8) * (1.0f / 1024.0f) + EPS);
        float ss = 0.f;
#pragma unroll
        for (int fb = 0; fb < NFB; ++fb)
#pragma unroll
            for (int g = 0; g < 4; ++g) {
                const float v0 = acc[fb][tb][4 * g] * r, v1 = acc[fb][tb][4 * g + 1] * r, v2 = acc[fb][tb][4 * g + 2] * r, v3 = acc[fb][tb][4 * g + 3] * r;
                ss += v0 * v0 + v1 * v1 + v2 * v2 + v3 * v3;
                u32x2 w; w.x = pk(v0, v1); w.y = pk(v2, v3);
                *(u32x2*)(wl + l31 * RB + (32 * fb + 8 * g + 4 * hh) * 2) = w;
            }
        if (ssslot >= 0) { ss += __shfl_xor(ss, 32); if (hh == 0) p.ss_p[t * 8 + ssslot] = ss; }
        const int rr = lane / CH, cc = lane % CH;
#pragma unroll
        for (int i = 0; i < 32 / RPP; ++i) {
            const int row = rr + RPP * i;
            const u32x4 w = *(const u32x4*)(wl + row * RB + cc * 16);
            *(u32x4*)(p.proj + (size_t)(tw + row) * NIN + col0 + 8 * cc) = w;
        }
    }
}

DI void phase_inproj(const Params& p, int layer, char* lds) {
    const bf16_t* W = p.WinT + (size_t)layer * 3104 * 1024;
    for (int item = blockIdx.x; item < 1536 + 64; item += gridDim.x) {
        if (item < 1536) {
            const int r = item >> 9, b = item & 511, x = b & 7, j = b >> 3;
            const int tt = 8 * x + (j >> 3), ft = 8 * r + (j & 7);
            f32x16 acc[4][2]; zero_acc(acc);
            gemm_tile<4, 2>(W + (size_t)ft * 128 * 1024, 1024, p.xb + (size_t)tt * 256 * 1024, 1024, 1024, lds, acc);
            const int slot = (ft >= 6 && ft < 14) ? ft - 6 : -1;
            epi_inproj<4>(p, acc, tt * 256, ft * 128, slot, lds);
        } else {
            const int tt = item - 1536;
            f32x16 acc[1][2]; zero_acc(acc);
            gemm_tile<1, 2>(W + (size_t)3072 * 1024, 1024, p.xb + (size_t)tt * 256 * 1024, 1024, 1024, lds, acc);
            epi_inproj<1>(p, acc, tt * 256, C_KR, -1, lds);
        }
    }
}

DI void epi_q(const Params& p, int layer, f32x16 (&acc)[3][2], int tok0, int head) {
    __builtin_amdgcn_sched_barrier(0);
    const int lane = otid() & 63, wave = otid() >> 6, l31 = lane & 31, hh = lane >> 5;
    const float* g = p.qk_q_g + layer * 96;
    const float QS = 0.10206207261596577f * 1.4426950408889634f;
#pragma unroll
    for (int tb = 0; tb < 2; ++tb) {
        const int t = tok0 + wave * 64 + tb * 32 + l31, pos = t & (SEQ - 1), bidx = t >> 13;
        const float* sp = p.ss_p + t * 8;
        const float rc = rsqrtf(((sp[0] + sp[1]) + (sp[2] + sp[3]) + (sp[4] + sp[5])) * (1.0f / 768.0f) + EPS);
        float ss = 0.f;
#pragma unroll
        for (int fb = 0; fb < 3; ++fb)
#pragma unroll
            for (int r = 0; r < 16; ++r) ss += acc[fb][tb][r] * acc[fb][tb][r];
        ss += __shfl_xor(ss, 32);
        const float rn = rc * rsqrtf(ss * rc * rc * (1.0f / 96.0f) + EPS);
        bf16_t* dst = p.Q + ((size_t)(bidx * 8 + head) * SEQ + pos) * 96 + 4 * hh;
#pragma unroll
        for (int fb = 0; fb < 2; ++fb)
#pragma unroll
            for (int gq = 0; gq < 4; ++gq) {
                const f32x4 gv = *(const f32x4*)(g + 32 * fb + 8 * gq + 4 * hh);
                const float s = rn * QS;
                u32x2 w; w.x = pk(acc[fb][tb][4 * gq] * s * gv.x, acc[fb][tb][4 * gq + 1] * s * gv.y);
                w.y = pk(acc[fb][tb][4 * gq + 2] * s * gv.z, acc[fb][tb][4 * gq + 3] * s * gv.w);
                *(u32x2*)(dst + 32 * fb + 8 * gq) = w;
            }
        const float* rp = p.rope + pos * 32;
#pragma unroll
        for (int gq = 0; gq < 2; ++gq) {
            const int i0 = 8 * gq + 4 * hh;
            const f32x4 c4 = *(const f32x4*)(rp + i0), s4 = *(const f32x4*)(rp + 16 + i0);
            const f32x4 g1 = *(const f32x4*)(g + 64 + i0), g2 = *(const f32x4*)(g + 80 + i0);
            float o1[4], o2[4];
#pragma unroll
            for (int i = 0; i < 4; ++i) {
                const float x1 = acc[2][tb][4 * gq + i] * rn * g1[i] * QS, x2 = acc[2][tb][4 * gq + i + 8] * rn * g2[i] * QS;
                o1[i] = x1 * c4[i] - x2 * s4[i]; o2[i] = x1 * s4[i] + x2 * c4[i];
            }
            u32x2 w1, w2; w1.x = pk(o1[0], o1[1]); w1.y = pk(o1[2], o1[3]); w2.x = pk(o2[0], o2[1]); w2.y = pk(o2[2], o2[3]);
            *(u32x2*)(dst + 64 + 8 * gq) = w1;
            *(u32x2*)(dst + 80 + 8 * gq) = w2;
        }
    }
}

DI void epi_kv(const Params& p, int layer, f32x16 (&acc)[4][2], int tok0, int head) {
    __builtin_amdgcn_sched_barrier(0);
    const int lane = otid() & 63, wave = otid() >> 6, l31 = lane & 31, hh = lane >> 5;
    const float* g = p.qk_k_g + layer * 96;
#pragma unroll
    for (int tb = 0; tb < 2; ++tb) {
        const int t = tok0 + wave * 64 + tb * 32 + l31, pos = t & (SEQ - 1), bidx = t >> 13;
        const float rc = rsqrtf((p.ss_p[t * 8 + 6] + p.ss_p[t * 8 + 7]) * (1.0f / 256.0f) + EPS);
        const int pp = (pos & ~15) | ((pos & 4) << 1) | ((pos & 8) >> 1) | (pos & 3);
        char* vbase = (char*)(p.VT + (size_t)((tok0 >> 13) * 8 + head) * 64 * SEQ);
        const unsigned voff = (unsigned)(4 * hh * SEQ + pp) * 2u;
#pragma unroll
        for (int fb = 2; fb < 4; ++fb)
#pragma unroll
            for (int r = 0; r < 16; ++r) {
                const int dvc = 32 * (fb - 2) + (r & 3) + 8 * (r >> 2);
                *(bf16_t*)(vbase + (size_t)dvc * SEQ * 2 + voff) = (bf16_t)(pk(acc[fb][tb][r] * rc, 0.f) & 0xffffu);
            }
        asm volatile("" ::: "memory");
        const bf16_t* kr = p.proj + (size_t)t * NIN + C_KR + 8 * hh;
        const u32x4 ka = *(const u32x4*)kr, kb = *(const u32x4*)(kr + 16);
        float x1[8], x2[8];
#pragma unroll
        for (int i = 0; i < 4; ++i) { x1[2 * i] = bflo(ka[i]); x1[2 * i + 1] = bfhi(ka[i]); x2[2 * i] = bflo(kb[i]); x2[2 * i + 1] = bfhi(kb[i]); }
        float ss = 0.f, sr = 0.f;
#pragma unroll
        for (int i = 0; i < 8; ++i) sr += x1[i] * x1[i] + x2[i] * x2[i];
#pragma unroll
        for (int fb = 0; fb < 2; ++fb)
#pragma unroll
            for (int r = 0; r < 16; ++r) ss += acc[fb][tb][r] * acc[fb][tb][r];
        ss = ss * rc * rc + sr;
        ss += __shfl_xor(ss, 32);
        const float rn = rsqrtf(ss * (1.0f / 96.0f) + EPS);
        const float rk = rn * rc;
        bf16_t* kd = p.K + ((size_t)(bidx * 8 + head) * SEQ + pos) * 96;
#pragma unroll
        for (int fb = 0; fb < 2; ++fb)
#pragma unroll
            for (int gq = 0; gq < 4; ++gq) {
                const int f = 32 * fb + 8 * gq + 4 * hh;
                const f32x4 gv = *(const f32x4*)(g + f);
                u32x2 w; w.x = pk(acc[fb][tb][4 * gq] * rk * gv.x, acc[fb][tb][4 * gq + 1] * rk * gv.y);
                w.y = pk(acc[fb][tb][4 * gq + 2] * rk * gv.z, acc[fb][tb][4 * gq + 3] * rk * gv.w);
                *(u32x2*)(kd + f) = w;
            }
        {
            const float* rp = p.rope + pos * 32 + 8 * hh;
            float o1[8], o2[8];
#pragma unroll
            for (int q4 = 0; q4 < 2; ++q4) {
                const f32x4 c4 = *(const f32x4*)(rp + 4 * q4), s4 = *(const f32x4*)(rp + 16 + 4 * q4);
                const f32x4 g1 = *(const f32x4*)(g + 64 + 8 * hh + 4 * q4), g2 = *(const f32x4*)(g + 80 + 8 * hh + 4 * q4);
#pragma unroll
                for (int i = 0; i < 4; ++i) {
                    const float a = x1[4 * q4 + i] * rn * g1[i], b = x2[4 * q4 + i] * rn * g2[i];
                    o1[4 * q4 + i] = a * c4[i] - b * s4[i]; o2[4 * q4 + i] = a * s4[i] + b * c4[i];
                }
            }
            u32x4 w1, w2;
            w1.x = pk(o1[0], o1[1]); w1.y = pk(o1[2], o1[3]); w1.z = pk(o1[4], o1[5]); w1.w = pk(o1[6], o1[7]);
            w2.x = pk(o2[0], o2[1]); w2.y = pk(o2[2], o2[3]); w2.z = pk(o2[4], o2[5]); w2.w = pk(o2[6], o2[7]);
            *(u32x4*)(kd + 64 + 8 * hh) = w1;
            *(u32x4*)(kd + 80 + 8 * hh) = w2;
        }
    }
}

DI void conv_item(const Params& p, int layer, int ct, char* lds) {
    const int tid = otid(), lane = tid & 63, wave = tid >> 6, l31 = lane & 31, hh = lane >> 5;
    constexpr int CR = 528;
    const int t0 = ct * 64, pos0 = t0 & (SEQ - 1);
    __syncthreads();
#pragma unroll 1
    for (int c0 = tid; c0 < 94 * 32; c0 += 1024) {
        u32x4 a[4], g[4];
#pragma unroll
        for (int u = 0; u < 4; ++u) {
            const int c = c0 + 256 * u, i = c >> 5, ch = c & 31;
            a[u] = (u32x4){0u, 0u, 0u, 0u}; g[u] = a[u];
            if (c < 94 * 32 && pos0 - 30 + i >= 0) {
                const bf16_t* src = p.proj + (size_t)(t0 - 30 + i) * NIN + 8 * ch;
                a[u] = *(const u32x4*)(src + C_A); g[u] = *(const u32x4*)(src + C_AG);
            }
        }
#pragma unroll
        for (int u = 0; u < 4; ++u) {
            const int c = c0 + 256 * u, i = c >> 5, ch = c & 31;
            if (c < 94 * 32) {
                u32x4 w;
#pragma unroll
                for (int e = 0; e < 4; ++e) w[e] = pk(bflo(a[u][e]) * sigmoidf_(bflo(g[u][e])), bfhi(a[u][e]) * sigmoidf_(bfhi(g[u][e])));
                *(u32x4*)(lds + i * CR + ch * 16) = w;
            }
        }
    }
    __syncthreads();
    {
        float w[31];
        const char* cw = (const char*)(p.conv_w + (size_t)layer * 31 * 256);
        const unsigned cwo = (unsigned)tid * 4u;
#pragma unroll
        for (int k = 0; k < 31; ++k) w[k] = *(const float*)(cw + k * 1024 + cwo);
        const float cb = p.conv_b[layer * 256 + tid];
#pragma unroll 1
        for (int tg = 0; tg < 8; ++tg) {
            float in[38];
            const char* base = lds + (8 * tg) * CR + 2 * tid;
#pragma unroll
            for (int i = 0; i < 38; ++i) in[i] = __uint_as_float((unsigned)(*(const bf16_t*)(base + i * CR)) << 16);
#pragma unroll
            for (int j = 0; j < 8; ++j) {
                float o = cb;
#pragma unroll
                for (int k = 0; k < 31; ++k) o += w[k] * in[j + k];
                *(bf16_t*)(lds + (8 * tg + j) * CR + 2 * tid) = (bf16_t)(pk(o, 0.f) & 0xffffu);
            }
        }
    }
    __syncthreads();
    {
        const int tok = tid >> 2, part = tid & 3;
        char* base = lds + tok * CR + part * 128;
        float v[64];
#pragma unroll
        for (int i = 0; i < 8; ++i) {
            const u32x4 w = *(const u32x4*)(base + 16 * i);
#pragma unroll
            for (int e = 0; e < 4; ++e) { v[8 * i + 2 * e] = bflo(w[e]); v[8 * i + 2 * e + 1] = bfhi(w[e]); }
        }
        float s = 0.f;
#pragma unroll
        for (int i = 0; i < 64; ++i) s += v[i];
        s += __shfl_xor(s, 1); s += __shfl_xor(s, 2);
        const float mu = s * (1.0f / 256.0f);
        float q = 0.f;
#pragma unroll
        for (int i = 0; i < 64; ++i) { const float d = v[i] - mu; q += d * d; }
        q += __shfl_xor(q, 1); q += __shfl_xor(q, 2);
        const float rs = rsqrtf(q * (1.0f / 256.0f) + EPS);
        const float* lg = p.conv_ln_g + layer * 256 + part * 64;
        const float* lb = p.conv_ln_b + layer * 256 + part * 64;
#pragma unroll
        for (int i = 0; i < 8; ++i) {
            const f32x4 g0 = *(const f32x4*)(lg + 8 * i), g1 = *(const f32x4*)(lg + 8 * i + 4);
            const f32x4 b0 = *(const f32x4*)(lb + 8 * i), b1 = *(const f32x4*)(lb + 8 * i + 4);
            float y[8];
#pragma unroll
            for (int e = 0; e < 4; ++e) { y[e] = siluf_((v[8 * i + e] - mu) * rs * g0[e] + b0[e]); y[4 + e] = siluf_((v[8 * i + 4 + e] - mu) * rs * g1[e] + b1[e]); }
            u32x4 w; w.x = pk(y[0], y[1]); w.y = pk(y[2], y[3]); w.z = pk(y[4], y[5]); w.w = pk(y[6], y[7]);
            *(u32x4*)(base + 16 * i) = w;
        }
    }
    __syncthreads();
    f32x16 acc[2][2]; zero_acc(acc);
    {
        const bf16_t* wsrc = p.PwT + (size_t)layer * 256 * 256 + (size_t)(64 * wave + l31) * 256 + 8 * hh;
        const char* tfp = lds + l31 * CR + hh * 16;
#pragma unroll 8
        for (int s = 0; s < 16; ++s) {
            bf16x8 wf[2], tf[2];
#pragma unroll
            for (int fb = 0; fb < 2; ++fb) wf[fb] = *(const bf16x8*)(wsrc + fb * 32 * 256 + 16 * s);
#pragma unroll
            for (int tb = 0; tb < 2; ++tb) tf[tb] = *(const bf16x8*)(tfp + tb * 32 * CR + s * 32);
#pragma unroll
            for (int fb = 0; fb < 2; ++fb)
#pragma unroll
                for (int tb = 0; tb < 2; ++tb) acc[fb][tb] = mfma(wf[fb], tf[tb], acc[fb][tb]);
        }
    }
    float* red = (float*)(lds + 49664);
    float ss[2] = {0.f, 0.f};
#pragma unroll
    for (int tb = 0; tb < 2; ++tb) {
        const int t = t0 + 32 * tb + l31;
#pragma unroll
        for (int fb = 0; fb < 2; ++fb)
#pragma unroll
            for (int gq = 0; gq < 4; ++gq) {
                const int f = 64 * wave + 32 * fb + 8 * gq + 4 * hh;
                const f32x4 bv = *(const f32x4*)(p.conv_pw_b + layer * 256 + f);
                const u32x2 z = *(const u32x2*)(p.proj + (size_t)t * NIN + C_ZC + f);
                const float v0 = (acc[fb][tb][4 * gq] + bv.x) * siluf_(bflo(z.x)), v1 = (acc[fb][tb][4 * gq + 1] + bv.y) * siluf_(bfhi(z.x));
                const float v2 = (acc[fb][tb][4 * gq + 2] + bv.z) * siluf_(bflo(z.y)), v3 = (acc[fb][tb][4 * gq + 3] + bv.w) * siluf_(bfhi(z.y));
                acc[fb][tb][4 * gq] = v0; acc[fb][tb][4 * gq + 1] = v1; acc[fb][tb][4 * gq + 2] = v2; acc[fb][tb][4 * gq + 3] = v3;
                ss[tb] += v0 * v0 + v1 * v1 + v2 * v2 + v3 * v3;
            }
        ss[tb] += __shfl_xor(ss[tb], 32);
        if (hh == 0) red[wave * 64 + 32 * tb + l31] = ss[tb];
    }
    __syncthreads();
#pragma unroll
    for (int tb = 0; tb < 2; ++tb) {
        const int t = t0 + 32 * tb + l31, ti = 32 * tb + l31;
        const float tot = (red[ti] + red[64 + ti]) + (red[128 + ti] + red[192 + ti]);
        const float rn = rsqrtf(tot * (1.0f / 256.0f) + EPS);
#pragma unroll
        for (int fb = 0; fb < 2; ++fb)
#pragma unroll
            for (int gq = 0; gq < 4; ++gq) {
                const int f = 64 * wave + 32 * fb + 8 * gq + 4 * hh;
                u32x2 w; w.x = pk(acc[fb][tb][4 * gq] * rn, acc[fb][tb][4 * gq + 1] * rn); w.y = pk(acc[fb][tb][4 * gq + 2] * rn, acc[fb][tb][4 * gq + 3] * rn);
                *(u32x2*)(p.Y + (size_t)t * 1024 + 768 + f) = w;
            }
    }
}

DI void sgu_item(const Params& p, int layer, int ch, char* lds) {
    const int tid = otid(), lane = tid & 63, wave = tid >> 6, l31 = lane & 31, hh = lane >> 5;
    constexpr int VR = 272;
    const int t0 = ch * 128;
    __syncthreads();
#pragma unroll 1
    for (int hf = 0; hf < 2; ++hf) {
        const int tok = 64 * hf + (tid >> 2), part = tid & 3;
        const bf16_t* src = p.proj + (size_t)(t0 + tok) * NIN + C_V;
        float v[64];
#pragma unroll
        for (int i = 0; i < 8; ++i) {
            const u32x4 w = *(const u32x4*)(src + 8 * (4 * i + part));
#pragma unroll
            for (int e = 0; e < 4; ++e) { v[8 * i + 2 * e] = geluf_(bflo(w[e])); v[8 * i + 2 * e + 1] = geluf_(bfhi(w[e])); }
        }
        float s = 0.f;
#pragma unroll
        for (int i = 0; i < 64; ++i) s += v[i];
        s += __shfl_xor(s, 1); s += __shfl_xor(s, 2);
        const float mu = s * (1.0f / 256.0f);
        float q = 0.f;
#pragma unroll
        for (int i = 0; i < 64; ++i) { const float d = v[i] - mu; q += d * d; }
        q += __shfl_xor(q, 1); q += __shfl_xor(q, 2);
        const float rs = rsqrtf(q * (1.0f / 256.0f) + EPS);
#pragma unroll
        for (int i = 0; i < 8; ++i) {
            const int c0 = 8 * (4 * i + part);
            const float* lg = p.sg_ln_g + layer * 256 + c0;
            const float* lb = p.sg_ln_b + layer * 256 + c0;
            const f32x4 g0 = *(const f32x4*)lg, g1 = *(const f32x4*)(lg + 4), b0 = *(const f32x4*)lb, b1 = *(const f32x4*)(lb + 4);
#pragma unroll
            for (int e = 0; e < 4; ++e) {
                const float y0 = (v[8 * i + e] - mu) * rs * g0[e] + b0[e], y1 = (v[8 * i + 4 + e] - mu) * rs * g1[e] + b1[e];
                *(bf16_t*)(lds + (c0 + e) * VR + tok * 2) = (bf16_t)(pk(y0, 0.f) & 0xffffu);
                *(bf16_t*)(lds + (c0 + 4 + e) * VR + tok * 2) = (bf16_t)(pk(y1, 0.f) & 0xffffu);
            }
        }
    }
    __syncthreads();
    const int tch = 32 * wave + l31, t = t0 + tch;
    float ss = 0.f;
#pragma unroll 1
    for (int hp = 0; hp < 2; ++hp) {
        f32x16 acc[4][1]; zero_acc(acc);
        const bf16_t* wsrc = p.SgW + ((size_t)(layer * 4 + 2 * hp) * 128 + 32 * wave + l31) * 128 + 8 * hh;
        const char* afp = lds + (128 * hp + l31) * VR + hh * 16;
        const int nsteps = 2 * (wave + 1);
        bf16x8 bfr[2][8];
#pragma unroll
        for (int s = 0; s < 8; ++s)
#pragma unroll
            for (int g = 0; g < 2; ++g) bfr[g][s] = (s < nsteps) ? *(const bf16x8*)(wsrc + (size_t)g * 128 * 128 + 16 * s) : (bf16x8){0, 0, 0, 0, 0, 0, 0, 0};
#pragma unroll
        for (int s = 0; s < 8; ++s) {
            if (s < nsteps) {
#pragma unroll
                for (int g = 0; g < 2; ++g)
#pragma unroll
                    for (int e = 0; e < 2; ++e) {
                        const int fb = 2 * g + e;
                        const bf16x8 afr = *(const bf16x8*)(afp + fb * 32 * VR + s * 32);
                        acc[fb][0] = mfma(afr, bfr[g][s], acc[fb][0]);
                    }
            }
        }
#pragma unroll
        for (int fb = 0; fb < 4; ++fb) {
            const float bias = p.sg_b[(layer * 4 + 2 * hp + (fb >> 1)) * 128 + tch];
#pragma unroll
            for (int gq = 0; gq < 4; ++gq) {
                const int f = 128 * hp + 32 * fb + 8 * gq + 4 * hh;
                const u32x2 u = *(const u32x2*)(p.proj + (size_t)t * NIN + C_U + f);
                const u32x2 z = *(const u32x2*)(p.proj + (size_t)t * NIN + C_ZS + f);
                const float v0 = geluf_(bflo(u.x)) * (acc[fb][0][4 * gq] + bias) * siluf_(bflo(z.x));
                const float v1 = geluf_(bfhi(u.x)) * (acc[fb][0][4 * gq + 1] + bias) * siluf_(bfhi(z.x));
                const float v2 = geluf_(bflo(u.y)) * (acc[fb][0][4 * gq + 2] + bias) * siluf_(bflo(z.y));
                const float v3 = geluf_(bfhi(u.y)) * (acc[fb][0][4 * gq + 3] + bias) * siluf_(bfhi(z.y));
                ss += v0 * v0 + v1 * v1 + v2 * v2 + v3 * v3;
                u32x2 w; w.x = pk(v0, v1); w.y = pk(v2, v3);
                *(u32x2*)(p.Y + (size_t)t * 1024 + 512 + f) = w;
            }
        }
    }
    (void)ss;
}

DI void phase_pre(const Params& p, int layer, char* lds) {
    for (int item = blockIdx.x; item < 512; item += gridDim.x) {
        const int x = item & 7, j = item >> 3, tt = 8 * x + (j >> 3), head = j & 7;
        f32x16 acc[3][2]; zero_acc(acc);
        gemm_tile<3, 2>(p.WuqT + (size_t)layer * 768 * 768 + (size_t)head * 96 * 768, 768, p.proj + (size_t)tt * 256 * NIN + C_CQ, NIN, 768, lds, acc);
        epi_q(p, layer, acc, tt * 256, head);
    }
    for (int item = blockIdx.x; item < 512; item += gridDim.x) {
        const int x = item & 7, j = item >> 3, tt = 8 * x + (j >> 3), head = j & 7;
        f32x16 acc[4][2]; zero_acc(acc);
        gemm_tile<4, 2>(p.WukvT + (size_t)layer * 1024 * 256 + (size_t)head * 128 * 256, 256, p.proj + (size_t)tt * 256 * NIN + C_CKV, NIN, 256, lds, acc);
        epi_kv(p, layer, acc, tt * 256, head);
    }
}

template <bool FIXED>
DI void attn_qtile(const Params& p, int bh, int qt, char* lds) {
    const int tid = otid(), lane = tid & 63, wave = tid >> 6, l31 = lane & 31, hh = lane >> 5;
    constexpr int KR = 208, KB = 64 * KR, VB = 64 * LROW, VOFF = 2 * KB;
    const int q0w = qt * 128 + 32 * wave;
    const bf16_t* Kg = p.K + (size_t)bh * SEQ * 96;
    const bf16_t* Vg = p.VT + (size_t)bh * 64 * SEQ;
    bf16x8 qf[6];
    {
        const bf16_t* qp = p.Q + ((size_t)bh * SEQ + q0w + l31) * 96 + 8 * hh;
#pragma unroll
        for (int s = 0; s < 6; ++s) qf[s] = *(const bf16x8*)(qp + 16 * s);
    }
    f32x16 O[2];
#pragma unroll
    for (int d = 0; d < 2; ++d)
#pragma unroll
        for (int r = 0; r < 16; ++r) O[d][r] = 0.f;
    float m = -1e30f, l = 0.f;
    const int ntiles = 2 * qt + 2;
    u32x2 zg[2][4];
    {
        const bf16_t* zp = p.proj + (size_t)((bh >> 3) * SEQ + q0w + l31) * NIN + C_ZM + (bh & 7) * 64 + 4 * hh;
#pragma unroll
        for (int d = 0; d < 2; ++d)
#pragma unroll
            for (int gq = 0; gq < 4; ++gq) zg[d][gq] = *(const u32x2*)(zp + 32 * d + 8 * gq);
    }
    u32x4 kreg[3], vreg[2];
    const int vdv = tid >> 3, vkc = tid & 7;
#define ATT_GLOAD(j) { \
        _Pragma("unroll") for (int i = 0; i < 3; ++i) kreg[i] = *(const u32x4*)(Kg + (size_t)(j) * 64 * 96 + (tid + 256 * i) * 8); \
        _Pragma("unroll") for (int i = 0; i < 2; ++i) vreg[i] = *(const u32x4*)(Vg + (size_t)(vdv + 32 * i) * SEQ + (j) * 64 + vkc * 8); }
#define ATT_LSTORE(buf) { \
        _Pragma("unroll") for (int i = 0; i < 3; ++i) { const int c = tid + 256 * i; *(u32x4*)(lds + (buf) * KB + (c / 12) * KR + (c % 12) * 16) = kreg[i]; } \
        _Pragma("unroll") for (int i = 0; i < 2; ++i) *(u32x4*)(lds + VOFF + (buf) * VB + (vdv + 32 * i) * LROW + vkc * 16) = vreg[i]; }
    __syncthreads();
    ATT_GLOAD(0);
    ATT_LSTORE(0);
    if (ntiles > 1) ATT_GLOAD(1);
    __syncthreads();
    for (int j = 0; j < ntiles; ++j) {
        const int kv0 = 64 * j;
        if (kv0 <= q0w + 31) {
            const char* Kb = lds + (j & 1) * KB + l31 * KR + hh * 16;
            const char* Vb = lds + VOFF + (j & 1) * VB + l31 * LROW + hh * 16;
            f32x16 sc[2];
            bf16x8 kf[2][6], vf[2][4];
#pragma unroll
            for (int kb = 0; kb < 2; ++kb)
#pragma unroll
                for (int s = 0; s < 6; ++s) kf[kb][s] = *(const bf16x8*)(Kb + kb * 32 * KR + s * 32);
            __builtin_amdgcn_sched_barrier(0);
#pragma unroll
            for (int kb = 0; kb < 2; ++kb)
#pragma unroll
                for (int r = 0; r < 16; ++r) sc[kb][r] = 0.f;
#pragma unroll
            for (int s = 0; s < 6; ++s)
#pragma unroll
                for (int kb = 0; kb < 2; ++kb) sc[kb] = mfma(kf[kb][s], qf[s], sc[kb]);
#pragma unroll
            for (int d = 0; d < 2; ++d)
#pragma unroll
                for (int ks = 0; ks < 4; ++ks) vf[d][ks] = *(const bf16x8*)(Vb + d * 32 * LROW + ks * 32);
            __builtin_amdgcn_sched_barrier(0);
            if (kv0 + 63 > q0w) {
                const int qi = q0w + l31;
#pragma unroll
                for (int kb = 0; kb < 2; ++kb)
#pragma unroll
                    for (int r = 0; r < 16; ++r) { const int key = kv0 + 32 * kb + crow(r, hh); if (key > qi) sc[kb][r] = -1e30f; }
            }
            if (FIXED) {
                f32x2 rs2 = {0.f, 0.f};
#pragma unroll
                for (int kb = 0; kb < 2; ++kb)
#pragma unroll
                    for (int r = 0; r < 16; r += 2) { const float p0 = fexp2(sc[kb][r]), p1 = fexp2(sc[kb][r + 1]); sc[kb][r] = p0; sc[kb][r + 1] = p1; rs2 += (f32x2){p0, p1}; }
                l += rs2.x + rs2.y;
            } else {
            float mx = -1e30f;
#pragma unroll
            for (int kb = 0; kb < 2; ++kb)
#pragma unroll
                for (int r = 0; r < 16; ++r) mx = fmaxf(mx, sc[kb][r]);
            mx = fmaxf(mx, __shfl_xor(mx, 32));
            const float mn = fmaxf(m, mx), alpha = fexp2(m - mn);
            m = mn;
            float rsum = 0.f;
#pragma unroll
            for (int kb = 0; kb < 2; ++kb)
#pragma unroll
                for (int r = 0; r < 16; ++r) { const float pv = fexp2(sc[kb][r] - mn); sc[kb][r] = pv; rsum += pv; }
            l = l * alpha + rsum;
#pragma unroll
            for (int d = 0; d < 2; ++d)
#pragma unroll
                for (int r = 0; r < 16; ++r) O[d][r] *= alpha;
            }
#pragma unroll
            for (int kb = 0; kb < 2; ++kb)
#pragma unroll
                for (int sp = 0; sp < 2; ++sp) {
                    u32x4 w;
                    w.x = pk(sc[kb][8 * sp], sc[kb][8 * sp + 1]); w.y = pk(sc[kb][8 * sp + 2], sc[kb][8 * sp + 3]);
                    w.z = pk(sc[kb][8 * sp + 4], sc[kb][8 * sp + 5]); w.w = pk(sc[kb][8 * sp + 6], sc[kb][8 * sp + 7]);
                    const bf16x8 pf = __builtin_bit_cast(bf16x8, w);
#pragma unroll
                    for (int d = 0; d < 2; ++d) O[d] = mfma(vf[d][2 * kb + sp], pf, O[d]);
                }
        }
        if (j + 1 < ntiles) {
            ATT_LSTORE((j + 1) & 1);
            if (j + 2 < ntiles) ATT_GLOAD(j + 2);
        }
        __syncthreads();
    }
#undef ATT_GLOAD
#undef ATT_LSTORE
    l += __shfl_xor(l, 32);
    const float inv = 1.0f / l;
    const int head = bh & 7, bidx = bh >> 3;
    const int t = bidx * SEQ + q0w + l31;
    float ss = 0.f;
#pragma unroll
    for (int d = 0; d < 2; ++d)
#pragma unroll
        for (int gq = 0; gq < 4; ++gq) {
            const int dv = 32 * d + 8 * gq + 4 * hh;
            const u32x2 z = zg[d][gq];
            const float v0 = O[d][4 * gq] * inv * siluf_(bflo(z.x)), v1 = O[d][4 * gq + 1] * inv * siluf_(bfhi(z.x));
            const float v2 = O[d][4 * gq + 2] * inv * siluf_(bflo(z.y)), v3 = O[d][4 * gq + 3] * inv * siluf_(bfhi(z.y));
            ss += v0 * v0 + v1 * v1 + v2 * v2 + v3 * v3;
            u32x2 w; w.x = pk(v0, v1); w.y = pk(v2, v3);
            *(u32x2*)(p.Y + (size_t)t * 1024 + head * 64 + dv) = w;
        }
    (void)ss;
}

DI void phase_attn(const Params& p, int layer, char* lds) {
    float gq = 0.f, gk = 0.f;
    for (int i = 0; i < 96; ++i) { gq = fmaxf(gq, fabsf(p.qk_q_g[layer * 96 + i])); gk = fmaxf(gk, fabsf(p.qk_k_g[layer * 96 + i])); }
    const bool fixed_ok = 96.0f * gq * gk * (0.10206207261596577f * 1.4426950408889634f) < 40.0f;
    for (int item = blockIdx.x; item < 256; item += gridDim.x) conv_item(p, layer, item, lds);
    for (int item = blockIdx.x; item < 512; item += gridDim.x) {
        const int bh = 2 * (item & 7) + (item >> 8), i = (item >> 3) & 31;
        if (fixed_ok) { attn_qtile<true>(p, bh, 63 - i, lds); attn_qtile<true>(p, bh, i, lds); }
        else { attn_qtile<false>(p, bh, 63 - i, lds); attn_qtile<false>(p, bh, i, lds); }
    }
    for (int item = gridDim.x - 1 - blockIdx.x; item < 128; item += gridDim.x) sgu_item(p, layer, item, lds);
}

DI void phase_norm(const Params& p) {
    const int lane = threadIdx.x & 63, wave = threadIdx.x >> 6;
    for (int t0 = (blockIdx.x * 4 + wave) * 4; t0 < NT; t0 += gridDim.x * 16) {
        u32x4 m[4]; u32x2 g[4];
#pragma unroll
        for (int r = 0; r < 4; ++r) { const bf16_t* row = p.Y + (size_t)(t0 + r) * 1024; m[r] = *(const u32x4*)(row + 8 * lane); g[r] = *(const u32x2*)(row + 512 + 4 * lane); }
        float sm[4], sg[4];
#pragma unroll
        for (int r = 0; r < 4; ++r) {
            sm[r] = 0.f; sg[r] = 0.f;
#pragma unroll
            for (int e = 0; e < 4; ++e) { const float a = bflo(m[r][e]), b = bfhi(m[r][e]); sm[r] += a * a + b * b; }
#pragma unroll
            for (int e = 0; e < 2; ++e) { const float a = bflo(g[r][e]), b = bfhi(g[r][e]); sg[r] += a * a + b * b; }
        }
#pragma unroll
        for (int o = 32; o >= 1; o >>= 1)
#pragma unroll
            for (int r = 0; r < 4; ++r) { sm[r] += __shfl_xor(sm[r], o); sg[r] += __shfl_xor(sg[r], o); }
#pragma unroll
        for (int r = 0; r < 4; ++r) {
            const float rm = rsqrtf(sm[r] * (1.0f / 512.0f) + EPS), rg = rsqrtf(sg[r] * (1.0f / 256.0f) + EPS);
            u32x4 mo; u32x2 go;
#pragma unroll
            for (int e = 0; e < 4; ++e) mo[e] = pk(bflo(m[r][e]) * rm, bfhi(m[r][e]) * rm);
#pragma unroll
            for (int e = 0; e < 2; ++e) go[e] = pk(bflo(g[r][e]) * rg, bfhi(g[r][e]) * rg);
            bf16_t* row = p.Y + (size_t)(t0 + r) * 1024;
            *(u32x4*)(row + 8 * lane) = mo;
            *(u32x2*)(row + 512 + 4 * lane) = go;
        }
    }
}

DI void phase_out(const Params& p, int layer, char* lds) {
    const int lane = otid() & 63, wave = otid() >> 6, l31 = lane & 31, hh = lane >> 5;
    const float* xin = layer == 0 ? p.x : p.out;
    const bf16_t* W = p.WoutT + (size_t)layer * 1024 * 1024;
    for (int item = blockIdx.x; item < 512; item += gridDim.x) {
        const int x = item & 7, j = item >> 3, tt = 8 * x + (j >> 3), ft = j & 7;
        f32x16 acc[4][2]; zero_acc(acc);
        const bf16_t* Wt = W + (size_t)ft * 128 * 1024;
        const bf16_t* Yt = p.Y + (size_t)tt * 256 * 1024;
        gemm_tile<4, 2>(Wt, 1024, Yt, 1024, 1024, lds, acc);
        {
            char* wl = lds + wave * (32 * 528);
            const int c = lane & 31, rh = lane >> 5;
            __syncthreads();
#pragma unroll
            for (int tb = 0; tb < 2; ++tb) {
                const int tw = tt * 256 + wave * 64 + tb * 32;
#pragma unroll
                for (int fb = 0; fb < 4; ++fb)
#pragma unroll
                    for (int gq = 0; gq < 4; ++gq) {
                        f32x4 v; v.x = acc[fb][tb][4 * gq]; v.y = acc[fb][tb][4 * gq + 1]; v.z = acc[fb][tb][4 * gq + 2]; v.w = acc[fb][tb][4 * gq + 3];
                        *(f32x4*)(wl + l31 * 528 + (32 * fb + 8 * gq + 4 * hh) * 4) = v;
                    }
#pragma unroll 4
                for (int i = 0; i < 16; ++i) {
                    const int row = 2 * i + rh, t = tw + row, f = ft * 128 + 4 * c;
                    const f32x4 v = *(const f32x4*)(wl + row * 528 + c * 16);
                    f32x4 xv = *(const f32x4*)(xin + (size_t)t * 1024 + f);
                    xv.x += v.x; xv.y += v.y; xv.z += v.z; xv.w += v.w;
                    *(f32x4*)(p.out + (size_t)t * 1024 + f) = xv;
                    if (layer == 0) {
                        u32x2 w; w.x = pk(xv.x, xv.y); w.y = pk(xv.z, xv.w);
                        *(u32x2*)(p.xb + (size_t)t * 1024 + f) = w;
                        float ss = xv.x * xv.x + xv.y * xv.y + xv.z * xv.z + xv.w * xv.w;
                        ss += __shfl_xor(ss, 16); ss += __shfl_xor(ss, 8); ss += __shfl_xor(ss, 4); ss += __shfl_xor(ss, 2); ss += __shfl_xor(ss, 1);
                        if (c == 0) p.ss_x[t * 8 + ft] = ss;
                    }
                }
            }
        }
    }
}


#define XB_TMO      128
#define XB_XCNT(j)  (256  + 64 * (j))
#define XB_XSUB(j)  (1280 + 64 * (j))
#define XB_XGEN(j)  (2304 + 64 * (j))
#define XB_TOP      3328
#define XB_TOPGEN   3392
#define XCD_BAR_WORDS 3456
#define XB_SPIN_CAP (1u << 20)
#define LAS __attribute__((address_space(3)))
DI unsigned xb_ld(unsigned* p)              { return __hip_atomic_load(p, __ATOMIC_RELAXED, __HIP_MEMORY_SCOPE_AGENT); }
DI unsigned xb_add(unsigned* p, unsigned v) { return __hip_atomic_fetch_add(p, v, __ATOMIC_RELAXED, __HIP_MEMORY_SCOPE_AGENT); }
DI unsigned xb_xcc_id() { return (unsigned)__builtin_amdgcn_s_getreg((3 << 11) | 20) & 0xFu; }
#define XB_SPIN(cond, bar) do { unsigned _sp = 0; while (cond) { __builtin_amdgcn_s_sleep(1); \
    if ((++_sp & 255u) == 0u) { if (xb_ld(&(bar)[XB_TMO])) break; if (_sp > XB_SPIN_CAP) { atomicAdd(&(bar)[XB_TMO], 1u); break; } } } } while (0)
struct XcdBarrier { unsigned* bar; unsigned x; volatile LAS unsigned* st; };
DI XcdBarrier xcd_barrier_post(unsigned* bar, volatile LAS unsigned* st) {
    XcdBarrier b; b.bar = bar; b.x = xb_xcc_id(); b.st = st;
    if (threadIdx.x == 0) (void)xb_add(&bar[XB_XCNT(b.x)], 1u);
    return b;
}
DI void xcd_barrier_complete(unsigned* bar, unsigned x, unsigned& nloc, unsigned& nx) {
    const unsigned G = gridDim.x * gridDim.y * gridDim.z;
    unsigned sum, cnt, mine, sp = 0u;
    for (;;) {
        sum = 0u; cnt = 0u; mine = 0u;
#pragma unroll
        for (unsigned j = 0; j < 16; ++j) { const unsigned c = xb_ld(&bar[XB_XCNT(j)]); sum += c; cnt += (c > 0u) ? 1u : 0u; mine = (j == x) ? c : mine; }
        if (sum == G) break;
        __builtin_amdgcn_s_sleep(1);
        if ((++sp & 255u) == 0u) { if (xb_ld(&bar[XB_TMO])) break; if (sp > XB_SPIN_CAP) { atomicAdd(&bar[XB_TMO], 1u); break; } }
    }
    nloc = mine > 0u ? mine : 1u; nx = cnt > 0u ? cnt : 1u;
}
DI void xcd_barrier(const XcdBarrier& b) {
    asm volatile("s_waitcnt vmcnt(0)" ::: "memory");
    __syncthreads();
    if (threadIdx.x == 0) {
        unsigned* bar = b.bar;
        __builtin_amdgcn_s_waitcnt(0);
        unsigned nloc = b.st[0], nx = b.st[1];
        if (nloc == 0u) { xcd_barrier_complete(bar, b.x, nloc, nx); b.st[0] = nloc; b.st[1] = nx; }
        const unsigned old = xb_add(&bar[XB_XSUB(b.x)], 1u);
        const unsigned gen = old / nloc;
        if (old + 1u == (gen + 1u) * nloc) {
            __builtin_amdgcn_fence(__ATOMIC_RELEASE, "agent");
            asm volatile("s_waitcnt vmcnt(0)" ::: "memory");
            const unsigned og = xb_add(&bar[XB_TOP], 1u);
            const unsigned tg = og / nx;
            if (og + 1u == (tg + 1u) * nx) xb_add(&bar[XB_TOPGEN], 1u);
            else XB_SPIN(xb_ld(&bar[XB_TOPGEN]) == tg, bar);
            __builtin_amdgcn_fence(__ATOMIC_ACQUIRE, "agent");
            xb_add(&bar[XB_XGEN(b.x)], 1u);
            asm volatile("s_waitcnt vmcnt(0)" ::: "memory");
        } else {
            XB_SPIN(xb_ld(&bar[XB_XGEN(b.x)]) == gen, bar);
            __builtin_amdgcn_fence(__ATOMIC_ACQUIRE, "agent");
            asm volatile("s_waitcnt vmcnt(0)" ::: "memory");
        }
    }
    __syncthreads();
}
#if MK_LAUNCHES == 1
DI void gsync(cg::grid_group& grid) {
    asm volatile("s_waitcnt vmcnt(0)" ::: "memory");
    grid.sync();
    __builtin_amdgcn_fence(__ATOMIC_ACQUIRE, "agent");
    asm volatile("s_waitcnt vmcnt(0)" ::: "memory");
}
__global__ void __launch_bounds__(256, 2) mega_kernel(Params p) {
    __shared__ __attribute__((aligned(16))) char lds[LDS_BYTES];
    __shared__ uint4 xb_words;
    cg::grid_group grid = cg::this_grid();
    if (threadIdx.x == 0) xb_words = make_uint4(0u, 0u, 0u, 0u);
    __syncthreads();
    for (int i = blockIdx.x * 256 + threadIdx.x; i < XCD_BAR_WORDS + 64; i += gridDim.x * 256) p.bar[i] = 0u;
    phase0(p, lds);
    gsync(grid);
    XcdBarrier xb = xcd_barrier_post(p.bar, (volatile LAS unsigned*)&xb_words);
#pragma unroll 1
    for (int layer = 0; layer < 2; ++layer) {
        phase_inproj(p, layer, lds);
        xcd_barrier(xb);
        phase_pre(p, layer, lds);
        xcd_barrier(xb);
        phase_attn(p, layer, lds);
        xcd_barrier(xb);
        phase_norm(p);
        xcd_barrier(xb);
        phase_out(p, layer, lds);
        if (layer == 0) xcd_barrier(xb);
    }
}
#endif

extern "C" void kernel_launch(void* const* d_in, const int* in_sizes, int n_in, void* d_out, int out_size, void* d_ws, size_t ws_size, hipStream_t stream) {
    Params p{};
    p.x = (const float*)d_in[0]; p.norm_g = (const float*)d_in[1]; p.w_in = (const float*)d_in[2]; p.conv_w = (const float*)d_in[3];
    p.conv_b = (const float*)d_in[4]; p.conv_ln_g = (const float*)d_in[5]; p.conv_ln_b = (const float*)d_in[6]; p.conv_pw_w = (const float*)d_in[7];
    p.conv_pw_b = (const float*)d_in[8]; p.q_norm_g = (const float*)d_in[9]; p.w_uq = (const float*)d_in[10]; p.kv_norm_g = (const float*)d_in[11];
    p.w_ukv = (const float*)d_in[12]; p.qk_q_g = (const float*)d_in[13]; p.qk_k_g = (const float*)d_in[14]; p.sg_ln_g = (const float*)d_in[15];
    p.sg_ln_b = (const float*)d_in[16]; p.sg_w = (const float*)d_in[17]; p.sg_b = (const float*)d_in[18]; p.branch_norm_g = (const float*)d_in[19];
    p.w_out = (const float*)d_in[20];
    p.out = (float*)d_out;
    char* ws = (char*)d_ws; size_t off = 0;
    auto take = [&](size_t bytes) { char* r = ws + off; off += (bytes + 255) & ~(size_t)255; return r; };
    p.proj = (bf16_t*)take((size_t)NT * NIN * 2);
    p.xb = (bf16_t*)take((size_t)NT * 1024 * 2);
    p.Q = (bf16_t*)take((size_t)16 * SEQ * 96 * 2);
    p.K = (bf16_t*)take((size_t)16 * SEQ * 96 * 2);
    p.VT = (bf16_t*)take((size_t)16 * 64 * SEQ * 2);
    p.Y = (bf16_t*)take((size_t)NT * 1024 * 2);
    p.WinT = (bf16_t*)take((size_t)2 * 3104 * 1024 * 2);
    p.WuqT = (bf16_t*)take((size_t)2 * 768 * 768 * 2);
    p.WukvT = (bf16_t*)take((size_t)2 * 1024 * 256 * 2);
    p.PwT = (bf16_t*)take((size_t)2 * 256 * 256 * 2);
    p.WoutT = (bf16_t*)take((size_t)2 * 1024 * 1024 * 2);
    p.SgW = (bf16_t*)take((size_t)2 * 4 * 128 * 128 * 2);
    p.ss_x = (float*)take((size_t)NT * 8 * 4);
    p.ss_p = (float*)take((size_t)NT * 8 * 4);
    p.ss_m = (float*)take((size_t)NT * 8 * 4);
    p.ss_s = (float*)take((size_t)NT * 4);
    p.rope = (float*)take((size_t)SEQ * 32 * 4);
    p.bar = (unsigned*)take(16384);
    for (int i = 0; i < 16; ++i) p.invf[i] = powf(10000.0f, -(float)i / 16.0f);
    if (off > ws_size) { fprintf(stderr, "workspace too small: need %zu have %zu\n", off, ws_size); return; }
#if MK_LAUNCHES == 1
    static int grid_blocks = 0;
    if (!grid_blocks) {
        int dev = 0, cus = 0, per_cu = 0;
        hipGetDevice(&dev);
        hipDeviceGetAttribute(&cus, hipDeviceAttributeMultiprocessorCount, dev);
        hipOccupancyMaxActiveBlocksPerMultiprocessor(&per_cu, mega_kernel, 256, 0);
        if (per_cu > 2) per_cu = 2;
        grid_blocks = cus * per_cu;
    }
    void* args[] = {&p};
    hipError_t e = hipLaunchCooperativeKernel((void*)mega_kernel, dim3(grid_blocks), dim3(256), args, 0, stream);
    if (e != hipSuccess) fprintf(stderr, "cooperative launch failed: %s (grid %d)\n", hipGetErrorString(e), grid_blocks);
#endif
}
```

```cpp
#include <hip/hip_runtime.h>
#include <hip/hip_cooperative_groups.h>
#include <cstdio>
#include <cmath>
namespace cg = cooperative_groups;

#ifndef MK_LAUNCHES
#define MK_LAUNCHES 1
#endif

typedef unsigned short bf16_t;
typedef short bf16x8 __attribute__((ext_vector_type(8)));
typedef float f32x16 __attribute__((ext_vector_type(16)));
typedef float f32x4 __attribute__((ext_vector_type(4)));
typedef float f32x2 __attribute__((ext_vector_type(2)));
typedef __bf16 bf2_t __attribute__((ext_vector_type(2)));
typedef unsigned u32x4 __attribute__((ext_vector_type(4)));
typedef unsigned u32x2 __attribute__((ext_vector_type(2)));
#define DI __device__ __forceinline__

constexpr int NT = 16384, SEQ = 8192, NIN = 3104;
constexpr int C_A = 0, C_AG = 256, C_ZC = 512, C_CQ = 768, C_CKV = 1536, C_ZM = 1792, C_U = 2304, C_V = 2560, C_ZS = 2816, C_KR = 3072;
constexpr int LROW = 144;
constexpr int LDS_BYTES = 69632;
constexpr float EPS = 1e-6f;

struct Params {
    const float* x; const float* norm_g; const float* w_in; const float* conv_w; const float* conv_b;
    const float* conv_ln_g; const float* conv_ln_b; const float* conv_pw_w; const float* conv_pw_b;
    const float* q_norm_g; const float* w_uq; const float* kv_norm_g; const float* w_ukv;
    const float* qk_q_g; const float* qk_k_g; const float* sg_ln_g; const float* sg_ln_b;
    const float* sg_w; const float* sg_b; const float* branch_norm_g; const float* w_out;
    float* out;
    bf16_t* proj; bf16_t* xb; bf16_t* Q; bf16_t* K; bf16_t* VT; bf16_t* Y;
    bf16_t* WinT; bf16_t* WuqT; bf16_t* WukvT; bf16_t* PwT; bf16_t* WoutT; bf16_t* SgW;
    float* ss_x; float* ss_p; float* ss_m; float* ss_s; float* rope;
    float invf[16];
    unsigned* bar; unsigned long long pad_;
};

DI unsigned pk(float lo, float hi) { f32x2 v = {lo, hi}; return __builtin_bit_cast(unsigned, __builtin_convertvector(v, bf2_t)); }
DI float bflo(unsigned w) { return __uint_as_float(w << 16); }
DI float bfhi(unsigned w) { return __uint_as_float(w & 0xffff0000u); }
DI float fexp2(float x) { return __builtin_amdgcn_exp2f(x); }
DI float rcpf_(float x) { return __builtin_amdgcn_rcpf(x); }
DI float sigmoidf_(float x) { return rcpf_(1.0f + __expf(-x)); }
DI float siluf_(float x) { return x * rcpf_(1.0f + __expf(-x)); }
DI float geluf_(float x) { const float u = 0.7978845608028654f * (x + 0.044715f * x * x * x); return x * rcpf_(1.0f + __expf(-2.0f * u)); }
DI unsigned opaque0() { unsigned z = 0; asm volatile("" : "+v"(z)); return z; }
DI int otid() { return (int)(threadIdx.x + opaque0()); }
DI int crow(int reg, int h) { return (reg & 3) + 8 * (reg >> 2) + 4 * h; }
DI f32x16 mfma(bf16x8 a, bf16x8 b, f32x16 c) { return __builtin_amdgcn_mfma_f32_32x32x16_bf16(a, b, c, 0, 0, 0); }
DI float sum8(const float* p) { const f32x4 a = *(const f32x4*)p, b = *(const f32x4*)(p + 4); return (a.x + a.y) + (a.z + a.w) + (b.x + b.y) + (b.z + b.w); }

template <int NFB, int NTB>
DI void gemm_tile(const bf16_t* __restrict__ Wp, int ldw, const bf16_t* __restrict__ Tp, int ldt, int K, char* lds, f32x16 (&acc)[NFB][NTB]) {
    constexpr int WROWS = NFB * 32, WCH = NFB, TCH = NTB * 4;
    char* ldsW = lds; char* ldsT = lds + WROWS * LROW;
    const int tid = otid(), lane = tid & 63, wave = tid >> 6, l31 = lane & 31, hh = lane >> 5;
    const int cr = tid >> 3, ckc = tid & 7;
    u32x4 wreg[WCH], treg[TCH];
    const bf16_t* wsrc = Wp + (size_t)cr * ldw + ckc * 8;
    const bf16_t* tsrc = Tp + (size_t)cr * ldt + ckc * 8;
#pragma unroll
    for (int i = 0; i < WCH; ++i) wreg[i] = *(const u32x4*)(wsrc + (size_t)(32 * i) * ldw);
#pragma unroll
    for (int i = 0; i < TCH; ++i) treg[i] = *(const u32x4*)(tsrc + (size_t)(32 * i) * ldt);
    const int nk = K >> 6;
    char* wdst = ldsW + cr * LROW + ckc * 16;
    char* tdst = ldsT + cr * LROW + ckc * 16;
    const char* wfp = ldsW + l31 * LROW + hh * 16;
    const char* tfp = ldsT + (wave * NTB * 32 + l31) * LROW + hh * 16;
    for (int kt = 0; kt < nk; ++kt) {
        __syncthreads();
#pragma unroll
        for (int i = 0; i < WCH; ++i) *(u32x4*)(wdst + 32 * i * LROW) = wreg[i];
#pragma unroll
        for (int i = 0; i < TCH; ++i) *(u32x4*)(tdst + 32 * i * LROW) = treg[i];
        __syncthreads();
        if (kt + 1 < nk) {
            const int ko = (kt + 1) * 64;
#pragma unroll
            for (int i = 0; i < WCH; ++i) wreg[i] = *(const u32x4*)(wsrc + (size_t)(32 * i) * ldw + ko);
#pragma unroll
            for (int i = 0; i < TCH; ++i) treg[i] = *(const u32x4*)(tsrc + (size_t)(32 * i) * ldt + ko);
        }
#pragma unroll
        for (int s = 0; s < 4; ++s) {
            bf16x8 wf[NFB], tf[NTB];
#pragma unroll
            for (int fb = 0; fb < NFB; ++fb) wf[fb] = *(const bf16x8*)(wfp + fb * 32 * LROW + s * 32);
#pragma unroll
            for (int tb = 0; tb < NTB; ++tb) tf[tb] = *(const bf16x8*)(tfp + tb * 32 * LROW + s * 32);
#pragma unroll
            for (int fb = 0; fb < NFB; ++fb)
#pragma unroll
                for (int tb = 0; tb < NTB; ++tb) acc[fb][tb] = mfma(wf[fb], tf[tb], acc[fb][tb]);
        }
    }
}

template <int NFB, int NTB> DI void zero_acc(f32x16 (&acc)[NFB][NTB]) {
#pragma unroll
    for (int a = 0; a < NFB; ++a)
#pragma unroll
        for (int b = 0; b < NTB; ++b)
#pragma unroll
            for (int r = 0; r < 16; ++r) acc[a][b][r] = 0.f;
}

DI void tconv_tile(const float* __restrict__ src, int ldsrc, int ks, int ns, int nvalid, const float* __restrict__ scale,
                   bf16_t* __restrict__ dst, int lddst, int kd, int nd, float* tile) {
    const int tid = threadIdx.x;
    __syncthreads();
    {
        const int n = tid & 63, kk = tid >> 6;
        float v[16];
#pragma unroll
        for (int r = 0; r < 16; ++r) v[r] = (n < nvalid) ? src[(size_t)(ks + r * 4 + kk) * ldsrc + ns + n] : 0.f;
        if (scale) {
#pragma unroll
            for (int r = 0; r < 16; ++r) v[r] *= scale[ks + r * 4 + kk];
        }
#pragma unroll
        for (int r = 0; r < 16; ++r) tile[(r * 4 + kk) * 65 + n] = v[r];
    }
    __syncthreads();
    {
        const int n = tid >> 2, kq = tid & 3;
        if (n < nvalid) {
            const float* tp = tile + (kq * 16) * 65 + n;
            u32x4 a, b;
            a.x = pk(tp[0 * 65], tp[1 * 65]);  a.y = pk(tp[2 * 65], tp[3 * 65]);   a.z = pk(tp[4 * 65], tp[5 * 65]);   a.w = pk(tp[6 * 65], tp[7 * 65]);
            b.x = pk(tp[8 * 65], tp[9 * 65]);  b.y = pk(tp[10 * 65], tp[11 * 65]); b.z = pk(tp[12 * 65], tp[13 * 65]); b.w = pk(tp[14 * 65], tp[15 * 65]);
            bf16_t* d = dst + (size_t)(nd + n) * lddst + kd + kq * 16;
            *(u32x4*)d = a; *(u32x4*)(d + 8) = b;
        }
    }
}

DI void phase0(const Params& p, char* lds) {
    float* tile = (float*)lds;
    const int tid = threadIdx.x, lane = tid & 63, wave = tid >> 6;
    for (int item = blockIdx.x; item < 2 * 1264; item += gridDim.x) {
        const int layer = item / 1264; int id = item % 1264;
        if (id < 784) {
            const int kt = id & 15, nt = id >> 4, nd = nt * 64;
            int ns, nv = 64;
            if (nd < 1792) ns = nd; else if (nd < 3072) ns = nd + 32; else { ns = 1792; nv = 32; }
            tconv_tile(p.w_in + (size_t)layer * 1024 * 3104, 3104, kt * 64, ns, nv, p.norm_g + layer * 1024,
                       p.WinT + (size_t)layer * 3104 * 1024, 1024, kt * 64, nd, tile);
        } else if ((id -= 784) < 144) {
            const int kt = id % 12, nt = id / 12;
            tconv_tile(p.w_uq + (size_t)layer * 768 * 768, 768, kt * 64, nt * 64, 64, p.q_norm_g + layer * 768,
                       p.WuqT + (size_t)layer * 768 * 768, 768, kt * 64, nt * 64, tile);
        } else if ((id -= 144) < 64) {
            const int kt = id & 3, nt = id >> 2;
            tconv_tile(p.w_ukv + (size_t)layer * 256 * 1024, 1024, kt * 64, nt * 64, 64, p.kv_norm_g + layer * 256,
                       p.WukvT + (size_t)layer * 1024 * 256, 256, kt * 64, nt * 64, tile);
        } else if ((id -= 64) < 16) {
            const int kt = id & 3, nt = id >> 2;
            tconv_tile(p.conv_pw_w + (size_t)layer * 256 * 256, 256, kt * 64, nt * 64, 64, nullptr,
                       p.PwT + (size_t)layer * 256 * 256, 256, kt * 64, nt * 64, tile);
        } else {
            id -= 16;
            const int kt = id & 15, nt = id >> 4, kd = kt * 64;
            const int ks = kd < 768 ? kd + 256 : kd - 768;
            tconv_tile(p.w_out + (size_t)layer * 1024 * 1024, 1024, ks, nt * 64, 64, p.branch_norm_g + layer * 1024,
                       p.WoutT + (size_t)layer * 1024 * 1024, 1024, kd, nt * 64, tile);
        }
    }
    const int gtid = blockIdx.x * 256 + tid, nthr = gridDim.x * 256;
    for (int e = gtid; e < 2 * 4 * 128 * 128; e += nthr) {
        const int t = (e >> 7) & 127, s = e & 127;
        p.SgW[e] = (bf16_t)(s <= t ? (pk(p.sg_w[e], 0.f) & 0xffffu) : 0u);
    }
    for (int e = gtid; e < SEQ * 16; e += nthr) {
        const int pos = e >> 4, i = e & 15;
        const float ang = (float)pos * p.invf[i];
        const double rev = (double)ang * 0.15915494309189535;
        const float fr = (float)(rev - floor(rev));
        p.rope[pos * 32 + i] = __builtin_amdgcn_cosf(fr);
        p.rope[pos * 32 + 16 + i] = __builtin_amdgcn_sinf(fr);
    }
    for (int row = (blockIdx.x * 4 + wave) * 2; row < NT; row += gridDim.x * 8) {
        f32x4 v[2][4];
#pragma unroll
        for (int rr = 0; rr < 2; ++rr)
#pragma unroll
            for (int i = 0; i < 4; ++i) v[rr][i] = ((const f32x4*)(p.x + (size_t)(row + rr) * 1024))[lane + 64 * i];
#pragma unroll
        for (int rr = 0; rr < 2; ++rr)
#pragma unroll
            for (int i = 0; i < 4; ++i) {
                const f32x4 a = v[rr][i];
                float ss = a.x * a.x + a.y * a.y + a.z * a.z + a.w * a.w;
                u32x2 w; w.x = pk(a.x, a.y); w.y = pk(a.z, a.w);
                *(u32x2*)(p.xb + (size_t)(row + rr) * 1024 + 4 * (lane + 64 * i)) = w;
                ss += __shfl_xor(ss, 16); ss += __shfl_xor(ss, 8); ss += __shfl_xor(ss, 4); ss += __shfl_xor(ss, 2); ss += __shfl_xor(ss, 1);
                if ((lane & 31) == 0) p.ss_x[(row + rr) * 8 + 2 * i + (lane >> 5)] = ss;
            }
    }
}

template <int NFB>
DI void epi_inproj(const Params& p, f32x16 (&acc)[NFB][2], int tok0, int col0, int ssslot, char* lds) {
    __builtin_amdgcn_sched_barrier(0);
    const int lane = otid() & 63, wave = otid() >> 6, l31 = lane & 31, hh = lane >> 5;
    constexpr int RB = NFB * 64 + 16;
    constexpr int CH = NFB * 4;
    constexpr int RPP = 64 / CH;
    char* wl = lds + wave * (32 * RB);
    __syncthreads();
#pragma unroll
    for (int tb = 0; tb < 2; ++tb) {
        const int tw = tok0 + wave * 64 + tb * 32;
        const int t = tw + l31;
        const float r = rsqrtf(sum8(p.ss_x + t * 8) * (1.0f / 1024.0f) + EPS);
        float ss = 0.f;
#pragma unroll
        for (int fb = 0; fb < NFB; ++fb)
#pragma unroll
            for (int g = 0; g < 4; ++g) {
                const float v0 = acc[fb][tb][4 * g] * r, v1 = acc[fb][tb][4 * g + 1] * r, v2 = acc[fb][tb][4 * g + 2] * r, v3 = acc[fb][tb][4 * g + 3] * r;
                ss += v0 * v0 + v1 * v1 + v2 * v2 + v3 * v3;
                u32x2 w; w.x = pk(v0, v1); w.y = pk(v2, v3);
                *(u32x2*)(wl + l31 * RB + (32 * fb + 8 * g + 4 * hh) * 2) = w;
            }
        if (ssslot >= 0) { ss += __shfl_xor(ss, 32); if (hh == 0) p.ss_p[t * 8 + ssslot] = ss; }
        const int rr = lane / CH, cc = lane % CH;
#pragma unroll
        for (int i = 0; i < 32 / RPP; ++i) {
            const int row = rr + RPP * i;
            const u32x4 w = *(const u32x4*)(wl + row * RB + cc * 16);
            *(u32x4*)(p.proj + (size_t)(tw + row) * NIN + col0 + 8 * cc) = w;
        }
    }
}

DI void phase_inproj(const Params& p, int layer, char* lds) {
    const bf16_t* W = p.WinT + (size_t)layer * 3104 * 1024;
    for (int item = blockIdx.x; item < 1536 + 64; item += gridDim.x) {
        if (item < 1536) {
            const int r = item >> 9, b = item & 511, x = b & 7, j = b >> 3;
            const int tt = 8 * x + (j >> 3), ft = 8 * r + (j & 7);
            f32x16 acc[4][2]; zero_acc(acc);
            gemm_tile<4, 2>(W + (size_t)ft * 128 * 1024, 1024, p.xb + (size_t)tt * 256 * 1024, 1024, 1024, lds, acc);
            const int slot = (ft >= 6 && ft < 14) ? ft - 6 : -1;
            epi_inproj<4>(p, acc, tt * 256, ft * 128, slot, lds);
        } else {
            const int tt = item - 1536;
            f32x16 acc[1][2]; zero_acc(acc);
            gemm_tile<1, 2>(W + (size_t)3072 * 1024, 1024, p.xb + (size_t)tt * 256 * 1024, 1024, 1024, lds, acc);
            epi_inproj<1>(p, acc, tt * 256, C_KR, -1, lds);
        }
    }
}

DI void epi_q(const Params& p, int layer, f32x16 (&acc)[3][2], int tok0, int head) {
    __builtin_amdgcn_sched_barrier(0);
    const int lane = otid() & 63, wave = otid() >> 6, l31 = lane & 31, hh = lane >> 5;
    const float* g = p.qk_q_g + layer * 96;
    const float QS = 0.10206207261596577f * 1.4426950408889634f;
#pragma unroll
    for (int tb = 0; tb < 2; ++tb) {
        const int t = tok0 + wave * 64 + tb * 32 + l31, pos = t & (SEQ - 1), bidx = t >> 13;
        const float* sp = p.ss_p + t * 8;
        const float rc = rsqrtf(((sp[0] + sp[1]) + (sp[2] + sp[3]) + (sp[4] + sp[5])) * (1.0f / 768.0f) + EPS);
        float ss = 0.f;
#pragma unroll
        for (int fb = 0; fb < 3; ++fb)
#pragma unroll
            for (int r = 0; r < 16; ++r) ss += acc[fb][tb][r] * acc[fb][tb][r];
        ss += __shfl_xor(ss, 32);
        const float rn = rc * rsqrtf(ss * rc * rc * (1.0f / 96.0f) + EPS);
        bf16_t* dst = p.Q + ((size_t)(bidx * 8 + head) * SEQ + pos) * 96 + 4 * hh;
#pragma unroll
        for (int fb = 0; fb < 2; ++fb)
#pragma unroll
            for (int gq = 0; gq < 4; ++gq) {
                const f32x4 gv = *(const f32x4*)(g + 32 * fb + 8 * gq + 4 * hh);
                const float s = rn * QS;
                u32x2 w; w.x = pk(acc[fb][tb][4 * gq] * s * gv.x, acc[fb][tb][4 * gq + 1] * s * gv.y);
                w.y = pk(acc[fb][tb][4 * gq + 2] * s * gv.z, acc[fb][tb][4 * gq + 3] * s * gv.w);
                *(u32x2*)(dst + 32 * fb + 8 * gq) = w;
            }
        const float* rp = p.rope + pos * 32;
#pragma unroll
        for (int gq = 0; gq < 2; ++gq) {
            const int i0 = 8 * gq + 4 * hh;
            const f32x4 c4 = *(const f32x4*)(rp + i0), s4 = *(const f32x4*)(rp + 16 + i0);
            const f32x4 g1 = *(const f32x4*)(g + 64 + i0), g2 = *(const f32x4*)(g + 80 + i0);
            float o1[4], o2[4];
#pragma unroll
            for (int i = 0; i < 4; ++i) {
                const float x1 = acc[2][tb][4 * gq + i] * rn * g1[i] * QS, x2 = acc[2][tb][4 * gq + i + 8] * rn * g2[i] * QS;
                o1[i] = x1 * c4[i] - x2 * s4[i]; o2[i] = x1 * s4[i] + x2 * c4[i];
            }
            u32x2 w1, w2; w1.x = pk(o1[0], o1[1]); w1.y = pk(o1[2], o1[3]); w2.x = pk(o2[0], o2[1]); w2.y = pk(o2[2], o2[3]);
            *(u32x2*)(dst + 64 + 8 * gq) = w1;
            *(u32x2*)(dst + 80 + 8 * gq) = w2;
        }
    }
}

DI void epi_kv(const Params& p, int layer, f32x16 (&acc)[4][2], int tok0, int head) {
    __builtin_amdgcn_sched_barrier(0);
    const int lane = otid() & 63, wave = otid() >> 6, l31 = lane & 31, hh = lane >> 5;
    const float* g = p.qk_k_g + layer * 96;
#pragma unroll
    for (int tb = 0; tb < 2; ++tb) {
        const int t = tok0 + wave * 64 + tb * 32 + l31, pos = t & (SEQ - 1), bidx = t >> 13;
        const float rc = rsqrtf((p.ss_p[t * 8 + 6] + p.ss_p[t * 8 + 7]) * (1.0f / 256.0f) + EPS);
        const int pp = (pos & ~15) | ((pos & 4) << 1) | ((pos & 8) >> 1) | (pos & 3);
        char* vbase = (char*)(p.VT + (size_t)((tok0 >> 13) * 8 + head) * 64 * SEQ);
        const unsigned voff = (unsigned)(4 * hh * SEQ + pp) * 2u;
#pragma unroll
        for (int fb = 2; fb < 4; ++fb)
#pragma unroll
            for (int r = 0; r < 16; ++r) {
                const int dvc = 32 * (fb - 2) + (r & 3) + 8 * (r >> 2);
                *(bf16_t*)(vbase + (size_t)dvc * SEQ * 2 + voff) = (bf16_t)(pk(acc[fb][tb][r] * rc, 0.f) & 0xffffu);
            }
        asm volatile("" ::: "memory");
        const bf16_t* kr = p.proj + (size_t)t * NIN + C_KR + 8 * hh;
        const u32x4 ka = *(const u32x4*)kr, kb = *(const u32x4*)(kr + 16);
        float x1[8], x2[8];
#pragma unroll
        for (int i = 0; i < 4; ++i) { x1[2 * i] = bflo(ka[i]); x1[2 * i + 1] = bfhi(ka[i]); x2[2 * i] = bflo(kb[i]); x2[2 * i + 1] = bfhi(kb[i]); }
        float ss = 0.f, sr = 0.f;
#pragma unroll
        for (int i = 0; i < 8; ++i) sr += x1[i] * x1[i] + x2[i] * x2[i];
#pragma unroll
        for (int fb = 0; fb < 2; ++fb)
#pragma unroll
            for (int r = 0; r < 16; ++r) ss += acc[fb][tb][r] * acc[fb][tb][r];
        ss = ss * rc * rc + sr;
        ss += __shfl_xor(ss, 32);
        const float rn = rsqrtf(ss * (1.0f / 96.0f) + EPS);
        const float rk = rn * rc;
        bf16_t* kd = p.K + ((size_t)(bidx * 8 + head) * SEQ + pos) * 96;
#pragma unroll
        for (int fb = 0; fb < 2; ++fb)
#pragma unroll
            for (int gq = 0; gq < 4; ++gq) {
                const int f = 32 * fb + 8 * gq + 4 * hh;
                const f32x4 gv = *(const f32x4*)(g + f);
                u32x2 w; w.x = pk(acc[fb][tb][4 * gq] * rk * gv.x, acc[fb][tb][4 * gq + 1] * rk * gv.y);
                w.y = pk(acc[fb][tb][4 * gq + 2] * rk * gv.z, acc[fb][tb][4 * gq + 3] * rk * gv.w);
                *(u32x2*)(kd + f) = w;
            }
        {
            const float* rp = p.rope + pos * 32 + 8 * hh;
            float o1[8], o2[8];
#pragma unroll
            for (int q4 = 0; q4 < 2; ++q4) {
                const f32x4 c4 = *(const f32x4*)(rp + 4 * q4), s4 = *(const f32x4*)(rp + 16 + 4 * q4);
                const f32x4 g1 = *(const f32x4*)(g + 64 + 8 * hh + 4 * q4), g2 = *(const f32x4*)(g + 80 + 8 * hh + 4 * q4);
#pragma unroll
                for (int i = 0; i < 4; ++i) {
                    const float a = x1[4 * q4 + i] * rn * g1[i], b = x2[4 * q4 + i] * rn * g2[i];
                    o1[4 * q4 + i] = a * c4[i] - b * s4[i]; o2[4 * q4 + i] = a * s4[i] + b * c4[i];
                }
            }
            u32x4 w1, w2;
            w1.x = pk(o1[0], o1[1]); w1.y = pk(o1[2], o1[3]); w1.z = pk(o1[4], o1[5]); w1.w = pk(o1[6], o1[7]);
            w2.x = pk(o2[0], o2[1]); w2.y = pk(o2[2], o2[3]); w2.z = pk(o2[4], o2[5]); w2.w = pk(o2[6], o2[7]);
            *(u32x4*)(kd + 64 + 8 * hh) = w1;
            *(u32x4*)(kd + 80 + 8 * hh) = w2;
        }
    }
}

DI void conv_item(const Params& p, int layer, int ct, char* lds) {
    const int tid = otid(), lane = tid & 63, wave = tid >> 6, l31 = lane & 31, hh = lane >> 5;
    constexpr int CR = 528;
    const int t0 = ct * 64, pos0 = t0 & (SEQ - 1);
    __syncthreads();
#pragma unroll 1
    for (int c0 = tid; c0 < 94 * 32; c0 += 1024) {
        u32x4 a[4], g[4];
#pragma unroll
        for (int u = 0; u < 4; ++u) {
            const int c = c0 + 256 * u, i = c >> 5, ch = c & 31;
            a[u] = (u32x4){0u, 0u, 0u, 0u}; g[u] = a[u];
            if (c < 94 * 32 && pos0 - 30 + i >= 0) {
                const bf16_t* src = p.proj + (size_t)(t0 - 30 + i) * NIN + 8 * ch;
                a[u] = *(const u32x4*)(src + C_A); g[u] = *(const u32x4*)(src + C_AG);
            }
        }
#pragma unroll
        for (int u = 0; u < 4; ++u) {
            const int c = c0 + 256 * u, i = c >> 5, ch = c & 31;
            if (c < 94 * 32) {
                u32x4 w;
#pragma unroll
                for (int e = 0; e < 4; ++e) w[e] = pk(bflo(a[u][e]) * sigmoidf_(bflo(g[u][e])), bfhi(a[u][e]) * sigmoidf_(bfhi(g[u][e])));
                *(u32x4*)(lds + i * CR + ch * 16) = w;
            }
        }
    }
    __syncthreads();
    {
        float w[31];
        const char* cw = (const char*)(p.conv_w + (size_t)layer * 31 * 256);
        const unsigned cwo = (unsigned)tid * 4u;
#pragma unroll
        for (int k = 0; k < 31; ++k) w[k] = *(const float*)(cw + k * 1024 + cwo);
        const float cb = p.conv_b[layer * 256 + tid];
#pragma unroll 1
        for (int tg = 0; tg < 8; ++tg) {
            float in[38];
            const char* base = lds + (8 * tg) * CR + 2 * tid;
#pragma unroll
            for (int i = 0; i < 38; ++i) in[i] = __uint_as_float((unsigned)(*(const bf16_t*)(base + i * CR)) << 16);
#pragma unroll
            for (int j = 0; j < 8; ++j) {
                float o = cb;
#pragma unroll
                for (int k = 0; k < 31; ++k) o += w[k] * in[j + k];
                *(bf16_t*)(lds + (8 * tg + j) * CR + 2 * tid) = (bf16_t)(pk(o, 0.f) & 0xffffu);
            }
        }
    }
    __syncthreads();
    {
        const int tok = tid >> 2, part = tid & 3;
        char* base = lds + tok * CR + part * 128;
        float v[64];
#pragma unroll
        for (int i = 0; i < 8; ++i) {
            const u32x4 w = *(const u32x4*)(base + 16 * i);
#pragma unroll
            for (int e = 0; e < 4; ++e) { v[8 * i + 2 * e] = bflo(w[e]); v[8 * i + 2 * e + 1] = bfhi(w[e]); }
        }
        float s = 0.f;
#pragma unroll
        for (int i = 0; i < 64; ++i) s += v[i];
        s += __shfl_xor(s, 1); s += __shfl_xor(s, 2);
        const float mu = s * (1.0f / 256.0f);
        float q = 0.f;
#pragma unroll
        for (int i = 0; i < 64; ++i) { const float d = v[i] - mu; q += d * d; }
        q += __shfl_xor(q, 1); q += __shfl_xor(q, 2);
        const float rs = rsqrtf(q * (1.0f / 256.0f) + EPS);
        const float* lg = p.conv_ln_g + layer * 256 + part * 64;
        const float* lb = p.conv_ln_b + layer * 256 + part * 64;
#pragma unroll
        for (int i = 0; i < 8; ++i) {
            const f32x4 g0 = *(const f32x4*)(lg + 8 * i), g1 = *(const f32x4*)(lg + 8 * i + 4);
            const f32x4 b0 = *(const f32x4*)(lb + 8 * i), b1 = *(const f32x4*)(lb + 8 * i + 4);
            float y[8];
#pragma unroll
            for (int e = 0; e < 4; ++e) { y[e] = siluf_((v[8 * i + e] - mu) * rs * g0[e] + b0[e]); y[4 + e] = siluf_((v[8 * i + 4 + e] - mu) * rs * g1[e] + b1[e]); }
            u32x4 w; w.x = pk(y[0], y[1]); w.y = pk(y[2], y[3]); w.z = pk(y[4], y[5]); w.w = pk(y[6], y[7]);
            *(u32x4*)(base + 16 * i) = w;
        }
    }
    __syncthreads();
    f32x16 acc[2][2]; zero_acc(acc);
    {
        const bf16_t* wsrc = p.PwT + (size_t)layer * 256 * 256 + (size_t)(64 * wave + l31) * 256 + 8 * hh;
        const char* tfp = lds + l31 * CR + hh * 16;
#pragma unroll 8
        for (int s = 0; s < 16; ++s) {
            bf16x8 wf[2], tf[2];
#pragma unroll
            for (int fb = 0; fb < 2; ++fb) wf[fb] = *(const bf16x8*)(wsrc + fb * 32 * 256 + 16 * s);
#pragma unroll
            for (int tb = 0; tb < 2; ++tb) tf[tb] = *(const bf16x8*)(tfp + tb * 32 * CR + s * 32);
#pragma unroll
            for (int fb = 0; fb < 2; ++fb)
#pragma unroll
                for (int tb = 0; tb < 2; ++tb) acc[fb][tb] = mfma(wf[fb], tf[tb], acc[fb][tb]);
        }
    }
    float* red = (float*)(lds + 49664);
    float ss[2] = {0.f, 0.f};
#pragma unroll
    for (int tb = 0; tb < 2; ++tb) {
        const int t = t0 + 32 * tb + l31;
#pragma unroll
        for (int fb = 0; fb < 2; ++fb)
#pragma unroll
            for (int gq = 0; gq < 4; ++gq) {
                const int f = 64 * wave + 32 * fb + 8 * gq + 4 * hh;
                const f32x4 bv = *(const f32x4*)(p.conv_pw_b + layer * 256 + f);
                const u32x2 z = *(const u32x2*)(p.proj + (size_t)t * NIN + C_ZC + f);
                const float v0 = (acc[fb][tb][4 * gq] + bv.x) * siluf_(bflo(z.x)), v1 = (acc[fb][tb][4 * gq + 1] + bv.y) * siluf_(bfhi(z.x));
                const float v2 = (acc[fb][tb][4 * gq + 2] + bv.z) * siluf_(bflo(z.y)), v3 = (acc[fb][tb][4 * gq + 3] + bv.w) * siluf_(bfhi(z.y));
                acc[fb][tb][4 * gq] = v0; acc[fb][tb][4 * gq + 1] = v1; acc[fb][tb][4 * gq + 2] = v2; acc[fb][tb][4 * gq + 3] = v3;
                ss[tb] += v0 * v0 + v1 * v1 + v2 * v2 + v3 * v3;
            }
        ss[tb] += __shfl_xor(ss[tb], 32);
        if (hh == 0) red[wave * 64 + 32 * tb + l31] = ss[tb];
    }
    __syncthreads();
#pragma unroll
    for (int tb = 0; tb < 2; ++tb) {
        const int t = t0 + 32 * tb + l31, ti = 32 * tb + l31;
        const float tot = (red[ti] + red[64 + ti]) + (red[128 + ti] + red[192 + ti]);
        const float rn = rsqrtf(tot * (1.0f / 256.0f) + EPS);
#pragma unroll
        for (int fb = 0; fb < 2; ++fb)
#pragma unroll
            for (int gq = 0; gq < 4; ++gq) {
                const int f = 64 * wave + 32 * fb + 8 * gq + 4 * hh;
                u32x2 w; w.x = pk(acc[fb][tb][4 * gq] * rn, acc[fb][tb][4 * gq + 1] * rn); w.y = pk(acc[fb][tb][4 * gq + 2] * rn, acc[fb][tb][4 * gq + 3] * rn);
                *(u32x2*)(p.Y + (size_t)t * 1024 + 768 + f) = w;
            }
    }
}

DI void sgu_item(const Params& p, int layer, int ch, char* lds) {
    const int tid = otid(), lane = tid & 63, wave = tid >> 6, l31 = lane & 31, hh = lane >> 5;
    constexpr int VR = 272;
    const int t0 = ch * 128;
    __syncthreads();
#pragma unroll 1
    for (int hf = 0; hf < 2; ++hf) {
        const int tok = 64 * hf + (tid >> 2), part = tid & 3;
        const bf16_t* src = p.proj + (size_t)(t0 + tok) * NIN + C_V;
        float v[64];
#pragma unroll
        for (int i = 0; i < 8; ++i) {
            const u32x4 w = *(const u32x4*)(src + 8 * (4 * i + part));
#pragma unroll
            for (int e = 0; e < 4; ++e) { v[8 * i + 2 * e] = geluf_(bflo(w[e])); v[8 * i + 2 * e + 1] = geluf_(bfhi(w[e])); }
        }
        float s = 0.f;
#pragma unroll
        for (int i = 0; i < 64; ++i) s += v[i];
        s += __shfl_xor(s, 1); s += __shfl_xor(s, 2);
        const float mu = s * (1.0f / 256.0f);
        float q = 0.f;
#pragma unroll
        for (int i = 0; i < 64; ++i) { const float d = v[i] - mu; q += d * d; }
        q += __shfl_xor(q, 1); q += __shfl_xor(q, 2);
        const float rs = rsqrtf(q * (1.0f / 256.0f) + EPS);
#pragma unroll
        for (int i = 0; i < 8; ++i) {
            const int c0 = 8 * (4 * i + part);
            const float* lg = p.sg_ln_g + layer * 256 + c0;
            const float* lb = p.sg_ln_b + layer * 256 + c0;
            const f32x4 g0 = *(const f32x4*)lg, g1 = *(const f32x4*)(lg + 4), b0 = *(const f32x4*)lb, b1 = *(const f32x4*)(lb + 4);
#pragma unroll
            for (int e = 0; e < 4; ++e) {
                const float y0 = (v[8 * i + e] - mu) * rs * g0[e] + b0[e], y1 = (v[8 * i + 4 + e] - mu) * rs * g1[e] + b1[e];
                *(bf16_t*)(lds + (c0 + e) * VR + tok * 2) = (bf16_t)(pk(y0, 0.f) & 0xffffu);
                *(bf16_t*)(lds + (c0 + 4 + e) * VR + tok * 2) = (bf16_t)(pk(y1, 0.f) & 0xffffu);
            }
        }
    }
    __syncthreads();
    const int tch = 32 * wave + l31, t = t0 + tch;
    float ss = 0.f;
#pragma unroll 1
    for (int hp = 0; hp < 2; ++hp) {
        f32x16 acc[4][1]; zero_acc(acc);
        const bf16_t* wsrc = p.SgW + ((size_t)(layer * 4 + 2 * hp) * 128 + 32 * wave + l31) * 128 + 8 * hh;
        const char* afp = lds + (128 * hp + l31) * VR + hh * 16;
        const int nsteps = 2 * (wave + 1);
        bf16x8 bfr[2][8];
#pragma unroll
        for (int s = 0; s < 8; ++s)
#pragma unroll
            for (int g = 0; g < 2; ++g) bfr[g][s] = (s < nsteps) ? *(const bf16x8*)(wsrc + (size_t)g * 128 * 128 + 16 * s) : (bf16x8){0, 0, 0, 0, 0, 0, 0, 0};
#pragma unroll
        for (int s = 0; s < 8; ++s) {
            if (s < nsteps) {
#pragma unroll
                for (int g = 0; g < 2; ++g)
#pragma unroll
                    for (int e = 0; e < 2; ++e) {
                        const int fb = 2 * g + e;
                        const bf16x8 afr = *(const bf16x8*)(afp + fb * 32 * VR + s * 32);
                        acc[fb][0] = mfma(afr, bfr[g][s], acc[fb][0]);
                    }
            }
        }
#pragma unroll
        for (int fb = 0; fb < 4; ++fb) {
            const float bias = p.sg_b[(layer * 4 + 2 * hp + (fb >> 1)) * 128 + tch];
#pragma unroll
            for (int gq = 0; gq < 4; ++gq) {
                const int f = 128 * hp + 32 * fb + 8 * gq + 4 * hh;
                const u32x2 u = *(const u32x2*)(p.proj + (size_t)t * NIN + C_U + f);
                const u32x2 z = *(const u32x2*)(p.proj + (size_t)t * NIN + C_ZS + f);
                const float v0 = geluf_(bflo(u.x)) * (acc[fb][0][4 * gq] + bias) * siluf_(bflo(z.x));
                const float v1 = geluf_(bfhi(u.x)) * (acc[fb][0][4 * gq + 1] + bias) * siluf_(bfhi(z.x));
                const float v2 = geluf_(bflo(u.y)) * (acc[fb][0][4 * gq + 2] + bias) * siluf_(bflo(z.y));
                const float v3 = geluf_(bfhi(u.y)) * (acc[fb][0][4 * gq + 3] + bias) * siluf_(bfhi(z.y));
                ss += v0 * v0 + v1 * v1 + v2 * v2 + v3 * v3;
                u32x2 w; w.x = pk(v0, v1); w.y = pk(v2, v3);
                *(u32x2*)(p.Y + (size_t)t * 1024 + 512 + f) = w;
            }
        }
    }
    (void)ss;
}

DI void phase_pre(const Params& p, int layer, char* lds) {
    for (int item = blockIdx.x; item < 512; item += gridDim.x) {
        const int x = item & 7, j = item >> 3, tt = 8 * x + (j >> 3), head = j & 7;
        f32x16 acc[3][2]; zero_acc(acc);
        gemm_tile<3, 2>(p.WuqT + (size_t)layer * 768 * 768 + (size_t)head * 96 * 768, 768, p.proj + (size_t)tt * 256 * NIN + C_CQ, NIN, 768, lds, acc);
        epi_q(p, layer, acc, tt * 256, head);
    }
    for (int item = blockIdx.x; item < 512; item += gridDim.x) {
        const int x = item & 7, j = item >> 3, tt = 8 * x + (j >> 3), head = j & 7;
        f32x16 acc[4][2]; zero_acc(acc);
        gemm_tile<4, 2>(p.WukvT + (size_t)layer * 1024 * 256 + (size_t)head * 128 * 256, 256, p.proj + (size_t)tt * 256 * NIN + C_CKV, NIN, 256, lds, acc);
        epi_kv(p, layer, acc, tt * 256, head);
    }
}

template <bool FIXED>
DI void attn_qtile(const Params& p, int bh, int qt, char* lds) {
    const int tid = otid(), lane = tid & 63, wave = tid >> 6, l31 = lane & 31, hh = lane >> 5;
    constexpr int KR = 208, KB = 64 * KR, VB = 64 * LROW, VOFF = 2 * KB;
    const int q0w = qt * 128 + 32 * wave;
    const bf16_t* Kg = p.K + (size_t)bh * SEQ * 96;
    const bf16_t* Vg = p.VT + (size_t)bh * 64 * SEQ;
    bf16x8 qf[6];
    {
        const bf16_t* qp = p.Q + ((size_t)bh * SEQ + q0w + l31) * 96 + 8 * hh;
#pragma unroll
        for (int s = 0; s < 6; ++s) qf[s] = *(const bf16x8*)(qp + 16 * s);
    }
    f32x16 O[2];
#pragma unroll
    for (int d = 0; d < 2; ++d)
#pragma unroll
        for (int r = 0; r < 16; ++r) O[d][r] = 0.f;
    float m = -1e30f, l = 0.f;
    const int ntiles = 2 * qt + 2;
    u32x4 kreg[3], vreg[2];
    const int vdv = tid >> 3, vkc = tid & 7;
#define ATT_GLOAD(j) { \
        _Pragma("unroll") for (int i = 0; i < 3; ++i) kreg[i] = *(const u32x4*)(Kg + (size_t)(j) * 64 * 96 + (tid + 256 * i) * 8); \
        _Pragma("unroll") for (int i = 0; i < 2; ++i) vreg[i] = *(const u32x4*)(Vg + (size_t)(vdv + 32 * i) * SEQ + (j) * 64 + vkc * 8); }
#define ATT_LSTORE(buf) { \
        _Pragma("unroll") for (int i = 0; i < 3; ++i) { const int c = tid + 256 * i; *(u32x4*)(lds + (buf) * KB + (c / 12) * KR + (c % 12) * 16) = kreg[i]; } \
        _Pragma("unroll") for (int i = 0; i < 2; ++i) *(u32x4*)(lds + VOFF + (buf) * VB + (vdv + 32 * i) * LROW + vkc * 16) = vreg[i]; }
    __syncthreads();
    ATT_GLOAD(0);
    ATT_LSTORE(0);
    if (ntiles > 1) ATT_GLOAD(1);
    __syncthreads();
    for (int j = 0; j < ntiles; ++j) {
        const int kv0 = 64 * j;
        if (kv0 <= q0w + 31) {
            const char* Kb = lds + (j & 1) * KB + l31 * KR + hh * 16;
            const char* Vb = lds + VOFF + (j & 1) * VB + l31 * LROW + hh * 16;
            f32x16 sc[2];
            bf16x8 kf[2][6], vf[2][4];
#pragma unroll
            for (int kb = 0; kb < 2; ++kb)
#pragma unroll
                for (int s = 0; s < 6; ++s) kf[kb][s] = *(const bf16x8*)(Kb + kb * 32 * KR + s * 32);
            __builtin_amdgcn_sched_barrier(0);
#pragma unroll
            for (int kb = 0; kb < 2; ++kb)
#pragma unroll
                for (int r = 0; r < 16; ++r) sc[kb][r] = 0.f;
#pragma unroll
            for (int s = 0; s < 6; ++s)
#pragma unroll
                for (int kb = 0; kb < 2; ++kb) sc[kb] = mfma(kf[kb][s], qf[s], sc[kb]);
#pragma unroll
            for (int d = 0; d < 2; ++d)
#pragma unroll
                for (int ks = 0; ks < 4; ++ks) vf[d][ks] = *(const bf16x8*)(Vb + d * 32 * LROW + ks * 32);
            __builtin_amdgcn_sched_barrier(0);
            if (kv0 + 63 > q0w) {
                const int qi = q0w + l31;
#pragma unroll
                for (int kb = 0; kb < 2; ++kb)
#pragma unroll
                    for (int r = 0; r < 16; ++r) { const int key = kv0 + 32 * kb + crow(r, hh); if (key > qi) sc[kb][r] = -1e30f; }
            }
            if (FIXED) {
                f32x2 rs2 = {0.f, 0.f};
#pragma unroll
                for (int kb = 0; kb < 2; ++kb)
#pragma unroll
                    for (int r = 0; r < 16; r += 2) { const float p0 = fexp2(sc[kb][r]), p1 = fexp2(sc[kb][r + 1]); sc[kb][r] = p0; sc[kb][r + 1] = p1; rs2 += (f32x2){p0, p1}; }
                l += rs2.x + rs2.y;
            } else {
            float mx = -1e30f;
#pragma unroll
            for (int kb = 0; kb < 2; ++kb)
#pragma unroll
                for (int r = 0; r < 16; ++r) mx = fmaxf(mx, sc[kb][r]);
            mx = fmaxf(mx, __shfl_xor(mx, 32));
            const float mn = fmaxf(m, mx), alpha = fexp2(m - mn);
            m = mn;
            float rsum = 0.f;
#pragma unroll
            for (int kb = 0; kb < 2; ++kb)
#pragma unroll
                for (int r = 0; r < 16; ++r) { const float pv = fexp2(sc[kb][r] - mn); sc[kb][r] = pv; rsum += pv; }
            l = l * alpha + rsum;
#pragma unroll
            for (int d = 0; d < 2; ++d)
#pragma unroll
                for (int r = 0; r < 16; ++r) O[d][r] *= alpha;
            }
#pragma unroll
            for (int kb = 0; kb < 2; ++kb)
#pragma unroll
                for (int sp = 0; sp < 2; ++sp) {
                    u32x4 w;
                    w.x = pk(sc[kb][8 * sp], sc[kb][8 * sp + 1]); w.y = pk(sc[kb][8 * sp + 2], sc[kb][8 * sp + 3]);
                    w.z = pk(sc[kb][8 * sp + 4], sc[kb][8 * sp + 5]); w.w = pk(sc[kb][8 * sp + 6], sc[kb][8 * sp + 7]);
                    const bf16x8 pf = __builtin_bit_cast(bf16x8, w);
#pragma unroll
                    for (int d = 0; d < 2; ++d) O[d] = mfma(vf[d][2 * kb + sp], pf, O[d]);
                }
        }
        if (j + 1 < ntiles) {
            ATT_LSTORE((j + 1) & 1);
            if (j + 2 < ntiles) ATT_GLOAD(j + 2);
        }
        __syncthreads();
    }
#undef ATT_GLOAD
#undef ATT_LSTORE
    l += __shfl_xor(l, 32);
    const float inv = 1.0f / l;
    const int head = bh & 7, bidx = bh >> 3;
    const int t = bidx * SEQ + q0w + l31;
    float ss = 0.f;
#pragma unroll
    for (int d = 0; d < 2; ++d)
#pragma unroll
        for (int gq = 0; gq < 4; ++gq) {
            const int dv = 32 * d + 8 * gq + 4 * hh;
            const u32x2 z = *(const u32x2*)(p.proj + (size_t)t * NIN + C_ZM + head * 64 + dv);
            const float v0 = O[d][4 * gq] * inv * siluf_(bflo(z.x)), v1 = O[d][4 * gq + 1] * inv * siluf_(bfhi(z.x));
            const float v2 = O[d][4 * gq + 2] * inv * siluf_(bflo(z.y)), v3 = O[d][4 * gq + 3] * inv * siluf_(bfhi(z.y));
            ss += v0 * v0 + v1 * v1 + v2 * v2 + v3 * v3;
            u32x2 w; w.x = pk(v0, v1); w.y = pk(v2, v3);
            *(u32x2*)(p.Y + (size_t)t * 1024 + head * 64 + dv) = w;
        }
    (void)ss;
}

DI void phase_attn(const Params& p, int layer, char* lds) {
    float gq = 0.f, gk = 0.f;
    for (int i = 0; i < 96; ++i) { gq = fmaxf(gq, fabsf(p.qk_q_g[layer * 96 + i])); gk = fmaxf(gk, fabsf(p.qk_k_g[layer * 96 + i])); }
    const bool fixed_ok = 96.0f * gq * gk * (0.10206207261596577f * 1.4426950408889634f) < 40.0f;
    for (int item = blockIdx.x; item < 256; item += gridDim.x) conv_item(p, layer, item, lds);
    for (int item = blockIdx.x; item < 512; item += gridDim.x) {
        const int bh = 2 * (item & 7) + (item >> 8), i = (item >> 3) & 31;
        if (fixed_ok) { attn_qtile<true>(p, bh, 63 - i, lds); attn_qtile<true>(p, bh, i, lds); }
        else { attn_qtile<false>(p, bh, 63 - i, lds); attn_qtile<false>(p, bh, i, lds); }
    }
    for (int item = gridDim.x - 1 - blockIdx.x; item < 128; item += gridDim.x) sgu_item(p, layer, item, lds);
}

DI void phase_norm(const Params& p) {
    const int lane = threadIdx.x & 63, wave = threadIdx.x >> 6;
    for (int t0 = (blockIdx.x * 4 + wave) * 4; t0 < NT; t0 += gridDim.x * 16) {
        u32x4 m[4]; u32x2 g[4];
#pragma unroll
        for (int r = 0; r < 4; ++r) { const bf16_t* row = p.Y + (size_t)(t0 + r) * 1024; m[r] = *(const u32x4*)(row + 8 * lane); g[r] = *(const u32x2*)(row + 512 + 4 * lane); }
        float sm[4], sg[4];
#pragma unroll
        for (int r = 0; r < 4; ++r) {
            sm[r] = 0.f; sg[r] = 0.f;
#pragma unroll
            for (int e = 0; e < 4; ++e) { const float a = bflo(m[r][e]), b = bfhi(m[r][e]); sm[r] += a * a + b * b; }
#pragma unroll
            for (int e = 0; e < 2; ++e) { const float a = bflo(g[r][e]), b = bfhi(g[r][e]); sg[r] += a * a + b * b; }
        }
#pragma unroll
        for (int o = 32; o >= 1; o >>= 1)
#pragma unroll
            for (int r = 0; r < 4; ++r) { sm[r] += __shfl_xor(sm[r], o); sg[r] += __shfl_xor(sg[r], o); }
#pragma unroll
        for (int r = 0; r < 4; ++r) {
            const float rm = rsqrtf(sm[r] * (1.0f / 512.0f) + EPS), rg = rsqrtf(sg[r] * (1.0f / 256.0f) + EPS);
            u32x4 mo; u32x2 go;
#pragma unroll
            for (int e = 0; e < 4; ++e) mo[e] = pk(bflo(m[r][e]) * rm, bfhi(m[r][e]) * rm);
#pragma unroll
            for (int e = 0; e < 2; ++e) go[e] = pk(bflo(g[r][e]) * rg, bfhi(g[r][e]) * rg);
            bf16_t* row = p.Y + (size_t)(t0 + r) * 1024;
            *(u32x4*)(row + 8 * lane) = mo;
            *(u32x2*)(row + 512 + 4 * lane) = go;
        }
    }
}

DI void phase_out(const Params& p, int layer, char* lds) {
    const int lane = otid() & 63, wave = otid() >> 6, l31 = lane & 31, hh = lane >> 5;
    const float* xin = layer == 0 ? p.x : p.out;
    const bf16_t* W = p.WoutT + (size_t)layer * 1024 * 1024;
    for (int item = blockIdx.x; item < 512; item += gridDim.x) {
        const int x = item & 7, j = item >> 3, tt = 8 * x + (j >> 3), ft = j & 7;
        f32x16 acc[4][2]; zero_acc(acc);
        const bf16_t* Wt = W + (size_t)ft * 128 * 1024;
        const bf16_t* Yt = p.Y + (size_t)tt * 256 * 1024;
        gemm_tile<4, 2>(Wt, 1024, Yt, 1024, 1024, lds, acc);
        {
            char* wl = lds + wave * (32 * 528);
            const int c = lane & 31, rh = lane >> 5;
            __syncthreads();
#pragma unroll
            for (int tb = 0; tb < 2; ++tb) {
                const int tw = tt * 256 + wave * 64 + tb * 32;
#pragma unroll
                for (int fb = 0; fb < 4; ++fb)
#pragma unroll
                    for (int gq = 0; gq < 4; ++gq) {
                        f32x4 v; v.x = acc[fb][tb][4 * gq]; v.y = acc[fb][tb][4 * gq + 1]; v.z = acc[fb][tb][4 * gq + 2]; v.w = acc[fb][tb][4 * gq + 3];
                        *(f32x4*)(wl + l31 * 528 + (32 * fb + 8 * gq + 4 * hh) * 4) = v;
                    }
#pragma unroll 4
                for (int i = 0; i < 16; ++i) {
                    const int row = 2 * i + rh, t = tw + row, f = ft * 128 + 4 * c;
                    const f32x4 v = *(const f32x4*)(wl + row * 528 + c * 16);
                    f32x4 xv = *(const f32x4*)(xin + (size_t)t * 1024 + f);
                    xv.x += v.x; xv.y += v.y; xv.z += v.z; xv.w += v.w;
                    *(f32x4*)(p.out + (size_t)t * 1024 + f) = xv;
                    if (layer == 0) {
                        u32x2 w; w.x = pk(xv.x, xv.y); w.y = pk(xv.z, xv.w);
                        *(u32x2*)(p.xb + (size_t)t * 1024 + f) = w;
                        float ss = xv.x * xv.x + xv.y * xv.y + xv.z * xv.z + xv.w * xv.w;
                        ss += __shfl_xor(ss, 16); ss += __shfl_xor(ss, 8); ss += __shfl_xor(ss, 4); ss += __shfl_xor(ss, 2); ss += __shfl_xor(ss, 1);
                        if (c == 0) p.ss_x[t * 8 + ft] = ss;
                    }
                }
            }
        }
    }
}


#define XB_TMO      128
#define XB_XCNT(j)  (256  + 64 * (j))
#define XB_XSUB(j)  (1280 + 64 * (j))
#define XB_XGEN(j)  (2304 + 64 * (j))
#define XB_TOP      3328
#define XB_TOPGEN   3392
#define XCD_BAR_WORDS 3456
#define XB_SPIN_CAP (1u << 20)
#define LAS __attribute__((address_space(3)))
DI unsigned xb_ld(unsigned* p)              { return __hip_atomic_load(p, __ATOMIC_RELAXED, __HIP_MEMORY_SCOPE_AGENT); }
DI unsigned xb_add(unsigned* p, unsigned v) { return __hip_atomic_fetch_add(p, v, __ATOMIC_RELAXED, __HIP_MEMORY_SCOPE_AGENT); }
DI unsigned xb_xcc_id() { return (unsigned)__builtin_amdgcn_s_getreg((3 << 11) | 20) & 0xFu; }
#define XB_SPIN(cond, bar) do { unsigned _sp = 0; while (cond) { __builtin_amdgcn_s_sleep(1); \
    if ((++_sp & 255u) == 0u) { if (xb_ld(&(bar)[XB_TMO])) break; if (_sp > XB_SPIN_CAP) { atomicAdd(&(bar)[XB_TMO], 1u); break; } } } } while (0)
struct XcdBarrier { unsigned* bar; unsigned x; volatile LAS unsigned* st; };
DI XcdBarrier xcd_barrier_post(unsigned* bar, volatile LAS unsigned* st) {
    XcdBarrier b; b.bar = bar; b.x = xb_xcc_id(); b.st = st;
    if (threadIdx.x == 0) (void)xb_add(&bar[XB_XCNT(b.x)], 1u);
    return b;
}
DI void xcd_barrier_complete(unsigned* bar, unsigned x, unsigned& nloc, unsigned& nx) {
    const unsigned G = gridDim.x * gridDim.y * gridDim.z;
    unsigned sum, cnt, mine, sp = 0u;
    for (;;) {
        sum = 0u; cnt = 0u; mine = 0u;
#pragma unroll
        for (unsigned j = 0; j < 16; ++j) { const unsigned c = xb_ld(&bar[XB_XCNT(j)]); sum += c; cnt += (c > 0u) ? 1u : 0u; mine = (j == x) ? c : mine; }
        if (sum == G) break;
        __builtin_amdgcn_s_sleep(1);
        if ((++sp & 255u) == 0u) { if (xb_ld(&bar[XB_TMO])) break; if (sp > XB_SPIN_CAP) { atomicAdd(&bar[XB_TMO], 1u); break; } }
    }
    nloc = mine > 0u ? mine : 1u; nx = cnt > 0u ? cnt : 1u;
}
DI void xcd_barrier(const XcdBarrier& b) {
    asm volatile("s_waitcnt vmcnt(0)" ::: "memory");
    __syncthreads();
    if (threadIdx.x == 0) {
        unsigned* bar = b.bar;
        __builtin_amdgcn_s_waitcnt(0);
        unsigned nloc = b.st[0], nx = b.st[1];
        if (nloc == 0u) { xcd_barrier_complete(bar, b.x, nloc, nx); b.st[0] = nloc; b.st[1] = nx; }
        const unsigned old = xb_add(&bar[XB_XSUB(b.x)], 1u);
        const unsigned gen = old / nloc;
        if (old + 1u == (gen + 1u) * nloc) {
            __builtin_amdgcn_fence(__ATOMIC_RELEASE, "agent");
            asm volatile("s_waitcnt vmcnt(0)" ::: "memory");
            const unsigned og = xb_add(&bar[XB_TOP], 1u);
            const unsigned tg = og / nx;
            if (og + 1u == (tg + 1u) * nx) xb_add(&bar[XB_TOPGEN], 1u);
            else XB_SPIN(xb_ld(&bar[XB_TOPGEN]) == tg, bar);
            __builtin_amdgcn_fence(__ATOMIC_ACQUIRE, "agent");
            xb_add(&bar[XB_XGEN(b.x)], 1u);
            asm volatile("s_waitcnt vmcnt(0)" ::: "memory");
        } else {
            XB_SPIN(xb_ld(&bar[XB_XGEN(b.x)]) == gen, bar);
            __builtin_amdgcn_fence(__ATOMIC_ACQUIRE, "agent");
            asm volatile("s_waitcnt vmcnt(0)" ::: "memory");
        }
    }
    __syncthreads();
}
#if MK_LAUNCHES == 1
DI void gsync(cg::grid_group& grid) {
    asm volatile("s_waitcnt vmcnt(0)" ::: "memory");
    grid.sync();
}
__global__ void __launch_bounds__(256, 2) mega_kernel(Params p) {
    __shared__ __attribute__((aligned(16))) char lds[LDS_BYTES];
    __shared__ uint4 xb_words;
    cg::grid_group grid = cg::this_grid();
    if (threadIdx.x == 0) xb_words = make_uint4(0u, 0u, 0u, 0u);
    __syncthreads();
    for (int i = blockIdx.x * 256 + threadIdx.x; i < XCD_BAR_WORDS + 64; i += gridDim.x * 256) p.bar[i] = 0u;
    phase0(p, lds);
    gsync(grid);
    XcdBarrier xb = xcd_barrier_post(p.bar, (volatile LAS unsigned*)&xb_words);
#pragma unroll 1
    for (int layer = 0; layer < 2; ++layer) {
        phase_inproj(p, layer, lds);
        xcd_barrier(xb);
        phase_pre(p, layer, lds);
        xcd_barrier(xb);
        phase_attn(p, layer, lds);
        xcd_barrier(xb);
        phase_norm(p);
        xcd_barrier(xb);
        phase_out(p, layer, lds);
        if (layer == 0) xcd_barrier(xb);
    }
}
#endif

extern "C" void kernel_launch(void* const* d_in, const int* in_sizes, int n_in, void* d_out, int out_size, void* d_ws, size_t ws_size, hipStream_t stream) {
    Params p{};
    p.x = (const float*)d_in[0]; p.norm_g = (const float*)d_in[1]; p.w_in = (const float*)d_in[2]; p.conv_w = (const float*)d_in[3];
    p.conv_b = (const float*)d_in[4]; p.conv_ln_g = (const float*)d_in[5]; p.conv_ln_b = (const float*)d_in[6]; p.conv_pw_w = (const float*)d_in[7];
    p.conv_pw_b = (const float*)d_in[8]; p.q_norm_g = (const float*)d_in[9]; p.w_uq = (const float*)d_in[10]; p.kv_norm_g = (const float*)d_in[11];
    p.w_ukv = (const float*)d_in[12]; p.qk_q_g = (const float*)d_in[13]; p.qk_k_g = (const float*)d_in[14]; p.sg_ln_g = (const float*)d_in[15];
    p.sg_ln_b = (const float*)d_in[16]; p.sg_w = (const float*)d_in[17]; p.sg_b = (const float*)d_in[18]; p.branch_norm_g = (const float*)d_in[19];
    p.w_out = (const float*)d_in[20];
    p.out = (float*)d_out;
    char* ws = (char*)d_ws; size_t off = 0;
    auto take = [&](size_t bytes) { char* r = ws + off; off += (bytes + 255) & ~(size_t)255; return r; };
    p.proj = (bf16_t*)take((size_t)NT * NIN * 2);
    p.xb = (bf16_t*)take((size_t)NT * 1024 * 2);
    p.Q = (bf16_t*)take((size_t)16 * SEQ * 96 * 2);
    p.K = (bf16_t*)take((size_t)16 * SEQ * 96 * 2);
    p.VT = (bf16_t*)take((size_t)16 * 64 * SEQ * 2);
    p.Y = (bf16_t*)take((size_t)NT * 1024 * 2);
    p.WinT = (bf16_t*)take((size_t)2 * 3104 * 1024 * 2);
    p.WuqT = (bf16_t*)take((size_t)2 * 768 * 768 * 2);
    p.WukvT = (bf16_t*)take((size_t)2 * 1024 * 256 * 2);
    p.PwT = (bf16_t*)take((size_t)2 * 256 * 256 * 2);
    p.WoutT = (bf16_t*)take((size_t)2 * 1024 * 1024 * 2);
    p.SgW = (bf16_t*)take((size_t)2 * 4 * 128 * 128 * 2);
    p.ss_x = (float*)take((size_t)NT * 8 * 4);
    p.ss_p = (float*)take((size_t)NT * 8 * 4);
    p.ss_m = (float*)take((size_t)NT * 8 * 4);
    p.ss_s = (float*)take((size_t)NT * 4);
    p.rope = (float*)take((size_t)SEQ * 32 * 4);
    p.bar = (unsigned*)take(16384);
    for (int i = 0; i < 16; ++i) p.invf[i] = powf(10000.0f, -(float)i / 16.0f);
    if (off > ws_size) { fprintf(stderr, "workspace too small: need %zu have %zu\n", off, ws_size); return; }
#if MK_LAUNCHES == 1
    static int grid_blocks = 0;
    if (!grid_blocks) {
        int dev = 0, cus = 0, per_cu = 0;
        hipGetDevice(&dev);
        hipDeviceGetAttribute(&cus, hipDeviceAttributeMultiprocessorCount, dev);
        hipOccupancyMaxActiveBlocksPerMultiprocessor(&per_cu, mega_kernel, 256, 0);
        if (per_cu > 2) per_cu = 2;
        grid_blocks = cus * per_cu;
    }
    void* args[] = {&p};
    hipError_t e = hipLaunchCooperativeKernel((void*)mega_kernel, dim3(grid_blocks), dim3(256), args, 0, stream);
    if (e != hipSuccess) fprintf(stderr, "cooperative launch failed: %s (grid %d)\n", hipGetErrorString(e), grid_blocks);
#endif
}
```

```cpp
#include <hip/hip_runtime.h>
#include <hip/hip_cooperative_groups.h>
#include <cstdio>
#include <cmath>
namespace cg = cooperative_groups;

#ifndef MK_LAUNCHES
#define MK_LAUNCHES 1
#endif

typedef unsigned short bf16_t;
typedef short bf16x8 __attribute__((ext_vector_type(8)));
typedef float f32x16 __attribute__((ext_vector_type(16)));
typedef float f32x4 __attribute__((ext_vector_type(4)));
typedef float f32x2 __attribute__((ext_vector_type(2)));
typedef __bf16 bf2_t __attribute__((ext_vector_type(2)));
typedef unsigned u32x4 __attribute__((ext_vector_type(4)));
typedef unsigned u32x2 __attribute__((ext_vector_type(2)));
#define DI __device__ __forceinline__

constexpr int NT = 16384, SEQ = 8192, NIN = 3104;
constexpr int C_A = 0, C_AG = 256, C_ZC = 512, C_CQ = 768, C_CKV = 1536, C_ZM = 1792, C_U = 2304, C_V = 2560, C_ZS = 2816, C_KR = 3072;
constexpr int LROW = 144;
constexpr int LDS_BYTES = 69632;
constexpr float EPS = 1e-6f;

struct Params {
    const float* x; const float* norm_g; const float* w_in; const float* conv_w; const float* conv_b;
    const float* conv_ln_g; const float* conv_ln_b; const float* conv_pw_w; const float* conv_pw_b;
    const float* q_norm_g; const float* w_uq; const float* kv_norm_g; const float* w_ukv;
    const float* qk_q_g; const float* qk_k_g; const float* sg_ln_g; const float* sg_ln_b;
    const float* sg_w; const float* sg_b; const float* branch_norm_g; const float* w_out;
    float* out;
    bf16_t* proj; bf16_t* xb; bf16_t* Q; bf16_t* K; bf16_t* VT; bf16_t* Y;
    bf16_t* WinT; bf16_t* WuqT; bf16_t* WukvT; bf16_t* PwT; bf16_t* WoutT; bf16_t* SgW;
    float* ss_x; float* ss_p; float* ss_m; float* ss_s; float* rope;
    float invf[16];
    unsigned* bar; unsigned long long pad_;
};

DI unsigned pk(float lo, float hi) { f32x2 v = {lo, hi}; return __builtin_bit_cast(unsigned, __builtin_convertvector(v, bf2_t)); }
DI float bflo(unsigned w) { return __uint_as_float(w << 16); }
DI float bfhi(unsigned w) { return __uint_as_float(w & 0xffff0000u); }
DI float fexp2(float x) { return __builtin_amdgcn_exp2f(x); }
DI float rcpf_(float x) { return __builtin_amdgcn_rcpf(x); }
DI float sigmoidf_(float x) { return rcpf_(1.0f + __expf(-x)); }
DI float siluf_(float x) { return x * rcpf_(1.0f + __expf(-x)); }
DI float geluf_(float x) { const float u = 0.7978845608028654f * (x + 0.044715f * x * x * x); return x * rcpf_(1.0f + __expf(-2.0f * u)); }
DI unsigned opaque0() { unsigned z = 0; asm volatile("" : "+v"(z)); return z; }
DI int otid() { return (int)(threadIdx.x + opaque0()); }
DI int crow(int reg, int h) { return (reg & 3) + 8 * (reg >> 2) + 4 * h; }
DI f32x16 mfma(bf16x8 a, bf16x8 b, f32x16 c) { return __builtin_amdgcn_mfma_f32_32x32x16_bf16(a, b, c, 0, 0, 0); }
DI float sum8(const float* p) { const f32x4 a = *(const f32x4*)p, b = *(const f32x4*)(p + 4); return (a.x + a.y) + (a.z + a.w) + (b.x + b.y) + (b.z + b.w); }

template <int NFB, int NTB>
DI void gemm_tile(const bf16_t* __restrict__ Wp, int ldw, const bf16_t* __restrict__ Tp, int ldt, int K, char* lds, f32x16 (&acc)[NFB][NTB]) {
    constexpr int WROWS = NFB * 32, WCH = NFB, TCH = NTB * 4;
    char* ldsW = lds; char* ldsT = lds + WROWS * LROW;
    const int tid = otid(), lane = tid & 63, wave = tid >> 6, l31 = lane & 31, hh = lane >> 5;
    const int cr = tid >> 3, ckc = tid & 7;
    u32x4 wreg[WCH], treg[TCH];
    const bf16_t* wsrc = Wp + (size_t)cr * ldw + ckc * 8;
    const bf16_t* tsrc = Tp + (size_t)cr * ldt + ckc * 8;
#pragma unroll
    for (int i = 0; i < WCH; ++i) wreg[i] = *(const u32x4*)(wsrc + (size_t)(32 * i) * ldw);
#pragma unroll
    for (int i = 0; i < TCH; ++i) treg[i] = *(const u32x4*)(tsrc + (size_t)(32 * i) * ldt);
    const int nk = K >> 6;
    char* wdst = ldsW + cr * LROW + ckc * 16;
    char* tdst = ldsT + cr * LROW + ckc * 16;
    const char* wfp = ldsW + l31 * LROW + hh * 16;
    const char* tfp = ldsT + (wave * NTB * 32 + l31) * LROW + hh * 16;
    for (int kt = 0; kt < nk; ++kt) {
        __syncthreads();
#pragma unroll
        for (int i = 0; i < WCH; ++i) *(u32x4*)(wdst + 32 * i * LROW) = wreg[i];
#pragma unroll
        for (int i = 0; i < TCH; ++i) *(u32x4*)(tdst + 32 * i * LROW) = treg[i];
        __syncthreads();
        if (kt + 1 < nk) {
            const int ko = (kt + 1) * 64;
#pragma unroll
            for (int i = 0; i < WCH; ++i) wreg[i] = *(const u32x4*)(wsrc + (size_t)(32 * i) * ldw + ko);
#pragma unroll
            for (int i = 0; i < TCH; ++i) treg[i] = *(const u32x4*)(tsrc + (size_t)(32 * i) * ldt + ko);
        }
#pragma unroll
        for (int s = 0; s < 4; ++s) {
            bf16x8 wf[NFB], tf[NTB];
#pragma unroll
            for (int fb = 0; fb < NFB; ++fb) wf[fb] = *(const bf16x8*)(wfp + fb * 32 * LROW + s * 32);
#pragma unroll
            for (int tb = 0; tb < NTB; ++tb) tf[tb] = *(const bf16x8*)(tfp + tb * 32 * LROW + s * 32);
#pragma unroll
            for (int fb = 0; fb < NFB; ++fb)
#pragma unroll
                for (int tb = 0; tb < NTB; ++tb) acc[fb][tb] = mfma(wf[fb], tf[tb], acc[fb][tb]);
        }
    }
}

template <int NFB, int NTB> DI void zero_acc(f32x16 (&acc)[NFB][NTB]) {
#pragma unroll
    for (int a = 0; a < NFB; ++a)
#pragma unroll
        for (int b = 0; b < NTB; ++b)
#pragma unroll
            for (int r = 0; r < 16; ++r) acc[a][b][r] = 0.f;
}

DI void tconv_tile(const float* __restrict__ src, int ldsrc, int ks, int ns, int nvalid, const float* __restrict__ scale,
                   bf16_t* __restrict__ dst, int lddst, int kd, int nd, float* tile) {
    const int tid = threadIdx.x;
    __syncthreads();
    {
        const int n = tid & 63, kk = tid >> 6;
        float v[16];
#pragma unroll
        for (int r = 0; r < 16; ++r) v[r] = (n < nvalid) ? src[(size_t)(ks + r * 4 + kk) * ldsrc + ns + n] : 0.f;
        if (scale) {
#pragma unroll
            for (int r = 0; r < 16; ++r) v[r] *= scale[ks + r * 4 + kk];
        }
#pragma unroll
        for (int r = 0; r < 16; ++r) tile[(r * 4 + kk) * 65 + n] = v[r];
    }
    __syncthreads();
    {
        const int n = tid >> 2, kq = tid & 3;
        if (n < nvalid) {
            const float* tp = tile + (kq * 16) * 65 + n;
            u32x4 a, b;
            a.x = pk(tp[0 * 65], tp[1 * 65]);  a.y = pk(tp[2 * 65], tp[3 * 65]);   a.z = pk(tp[4 * 65], tp[5 * 65]);   a.w = pk(tp[6 * 65], tp[7 * 65]);
            b.x = pk(tp[8 * 65], tp[9 * 65]);  b.y = pk(tp[10 * 65], tp[11 * 65]); b.z = pk(tp[12 * 65], tp[13 * 65]); b.w = pk(tp[14 * 65], tp[15 * 65]);
            bf16_t* d = dst + (size_t)(nd + n) * lddst + kd + kq * 16;
            *(u32x4*)d = a; *(u32x4*)(d + 8) = b;
        }
    }
}

DI void phase0(const Params& p, char* lds) {
    float* tile = (float*)lds;
    const int tid = threadIdx.x, lane = tid & 63, wave = tid >> 6;
    for (int item = blockIdx.x; item < 2 * 1264; item += gridDim.x) {
        const int layer = item / 1264; int id = item % 1264;
        if (id < 784) {
            const int kt = id & 15, nt = id >> 4, nd = nt * 64;
            int ns, nv = 64;
            if (nd < 1792) ns = nd; else if (nd < 3072) ns = nd + 32; else { ns = 1792; nv = 32; }
            tconv_tile(p.w_in + (size_t)layer * 1024 * 3104, 3104, kt * 64, ns, nv, p.norm_g + layer * 1024,
                       p.WinT + (size_t)layer * 3104 * 1024, 1024, kt * 64, nd, tile);
        } else if ((id -= 784) < 144) {
            const int kt = id % 12, nt = id / 12;
            tconv_tile(p.w_uq + (size_t)layer * 768 * 768, 768, kt * 64, nt * 64, 64, p.q_norm_g + layer * 768,
                       p.WuqT + (size_t)layer * 768 * 768, 768, kt * 64, nt * 64, tile);
        } else if ((id -= 144) < 64) {
            const int kt = id & 3, nt = id >> 2;
            tconv_tile(p.w_ukv + (size_t)layer * 256 * 1024, 1024, kt * 64, nt * 64, 64, p.kv_norm_g + layer * 256,
                       p.WukvT + (size_t)layer * 1024 * 256, 256, kt * 64, nt * 64, tile);
        } else if ((id -= 64) < 16) {
            const int kt = id & 3, nt = id >> 2;
            tconv_tile(p.conv_pw_w + (size_t)layer * 256 * 256, 256, kt * 64, nt * 64, 64, nullptr,
                       p.PwT + (size_t)layer * 256 * 256, 256, kt * 64, nt * 64, tile);
        } else {
            id -= 16;
            const int kt = id & 15, nt = id >> 4, kd = kt * 64;
            const int ks = kd < 768 ? kd + 256 : kd - 768;
            tconv_tile(p.w_out + (size_t)layer * 1024 * 1024, 1024, ks, nt * 64, 64, p.branch_norm_g + layer * 1024,
                       p.WoutT + (size_t)layer * 1024 * 1024, 1024, kd, nt * 64, tile);
        }
    }
    const int gtid = blockIdx.x * 256 + tid, nthr = gridDim.x * 256;
    for (int e = gtid; e < 2 * 4 * 128 * 128; e += nthr) {
        const int t = (e >> 7) & 127, s = e & 127;
        p.SgW[e] = (bf16_t)(s <= t ? (pk(p.sg_w[e], 0.f) & 0xffffu) : 0u);
    }
    for (int e = gtid; e < SEQ * 16; e += nthr) {
        const int pos = e >> 4, i = e & 15;
        const float ang = (float)pos * p.invf[i];
        const double rev = (double)ang * 0.15915494309189535;
        const float fr = (float)(rev - floor(rev));
        p.rope[pos * 32 + i] = __builtin_amdgcn_cosf(fr);
        p.rope[pos * 32 + 16 + i] = __builtin_amdgcn_sinf(fr);
    }
    for (int row = (blockIdx.x * 4 + wave) * 2; row < NT; row += gridDim.x * 8) {
        f32x4 v[2][4];
#pragma unroll
        for (int rr = 0; rr < 2; ++rr)
#pragma unroll
            for (int i = 0; i < 4; ++i) v[rr][i] = ((const f32x4*)(p.x + (size_t)(row + rr) * 1024))[lane + 64 * i];
#pragma unroll
        for (int rr = 0; rr < 2; ++rr)
#pragma unroll
            for (int i = 0; i < 4; ++i) {
                const f32x4 a = v[rr][i];
                float ss = a.x * a.x + a.y * a.y + a.z * a.z + a.w * a.w;
                u32x2 w; w.x = pk(a.x, a.y); w.y = pk(a.z, a.w);
                *(u32x2*)(p.xb + (size_t)(row + rr) * 1024 + 4 * (lane + 64 * i)) = w;
                ss += __shfl_xor(ss, 16); ss += __shfl_xor(ss, 8); ss += __shfl_xor(ss, 4); ss += __shfl_xor(ss, 2); ss += __shfl_xor(ss, 1);
                if ((lane & 31) == 0) p.ss_x[(row + rr) * 8 + 2 * i + (lane >> 5)] = ss;
            }
    }
}

template <int NFB>
DI void epi_inproj(const Params& p, f32x16 (&acc)[NFB][2], int tok0, int col0, int ssslot, char* lds) {
    __builtin_amdgcn_sched_barrier(0);
    const int lane = otid() & 63, wave = otid() >> 6, l31 = lane & 31, hh = lane >> 5;
    constexpr int RB = NFB * 64 + 16;
    constexpr int CH = NFB * 4;
    constexpr int RPP = 64 / CH;
    char* wl = lds + wave * (32 * RB);
    __syncthreads();
#pragma unroll
    for (int tb = 0; tb < 2; ++tb) {
        const int tw = tok0 + wave * 64 + tb * 32;
        const int t = tw + l31;
        const float r = rsqrtf(sum8(p.ss_x + t * 8) * (1.0f / 1024.0f) + EPS);
        float ss = 0.f;
#pragma unroll
        for (int fb = 0; fb < NFB; ++fb)
#pragma unroll
            for (int g = 0; g < 4; ++g) {
                const float v0 = acc[fb][tb][4 * g] * r, v1 = acc[fb][tb][4 * g + 1] * r, v2 = acc[fb][tb][4 * g + 2] * r, v3 = acc[fb][tb][4 * g + 3] * r;
                ss += v0 * v0 + v1 * v1 + v2 * v2 + v3 * v3;
                u32x2 w; w.x = pk(v0, v1); w.y = pk(v2, v3);
                *(u32x2*)(wl + l31 * RB + (32 * fb + 8 * g + 4 * hh) * 2) = w;
            }
        if (ssslot >= 0) { ss += __shfl_xor(ss, 32); if (hh == 0) p.ss_p[t * 8 + ssslot] = ss; }
        const int rr = lane / CH, cc = lane % CH;
#pragma unroll
        for (int i = 0; i < 32 / RPP; ++i) {
            const int row = rr + RPP * i;
            const u32x4 w = *(const u32x4*)(wl + row * RB + cc * 16);
            *(u32x4*)(p.proj + (size_t)(tw + row) * NIN + col0 + 8 * cc) = w;
        }
    }
}

DI void phase_inproj(const Params& p, int layer, char* lds) {
    const bf16_t* W = p.WinT + (size_t)layer * 3104 * 1024;
    for (int item = blockIdx.x; item < 1536 + 64; item += gridDim.x) {
        if (item < 1536) {
            const int r = item >> 9, b = item & 511, x = b & 7, j = b >> 3;
            const int tt = 8 * x + (j >> 3), ft = 8 * r + (j & 7);
            f32x16 acc[4][2]; zero_acc(acc);
            gemm_tile<4, 2>(W + (size_t)ft * 128 * 1024, 1024, p.xb + (size_t)tt * 256 * 1024, 1024, 1024, lds, acc);
            const int slot = (ft >= 6 && ft < 14) ? ft - 6 : -1;
            epi_inproj<4>(p, acc, tt * 256, ft * 128, slot, lds);
        } else {
            const int tt = item - 1536;
            f32x16 acc[1][2]; zero_acc(acc);
            gemm_tile<1, 2>(W + (size_t)3072 * 1024, 1024, p.xb + (size_t)tt * 256 * 1024, 1024, 1024, lds, acc);
            epi_inproj<1>(p, acc, tt * 256, C_KR, -1, lds);
        }
    }
}

DI void epi_q(const Params& p, int layer, f32x16 (&acc)[3][2], int tok0, int head) {
    __builtin_amdgcn_sched_barrier(0);
    const int lane = otid() & 63, wave = otid() >> 6, l31 = lane & 31, hh = lane >> 5;
    const float* g = p.qk_q_g + layer * 96;
    const float QS = 0.10206207261596577f * 1.4426950408889634f;
#pragma unroll
    for (int tb = 0; tb < 2; ++tb) {
        const int t = tok0 + wave * 64 + tb * 32 + l31, pos = t & (SEQ - 1), bidx = t >> 13;
        const float* sp = p.ss_p + t * 8;
        const float rc = rsqrtf(((sp[0] + sp[1]) + (sp[2] + sp[3]) + (sp[4] + sp[5])) * (1.0f / 768.0f) + EPS);
        float ss = 0.f;
#pragma unroll
        for (int fb = 0; fb < 3; ++fb)
#pragma unroll
            for (int r = 0; r < 16; ++r) ss += acc[fb][tb][r] * acc[fb][tb][r];
        ss += __shfl_xor(ss, 32);
        const float rn = rc * rsqrtf(ss * rc * rc * (1.0f / 96.0f) + EPS);
        bf16_t* dst = p.Q + ((size_t)(bidx * 8 + head) * SEQ + pos) * 96 + 4 * hh;
#pragma unroll
        for (int fb = 0; fb < 2; ++fb)
#pragma unroll
            for (int gq = 0; gq < 4; ++gq) {
                const f32x4 gv = *(const f32x4*)(g + 32 * fb + 8 * gq + 4 * hh);
                const float s = rn * QS;
                u32x2 w; w.x = pk(acc[fb][tb][4 * gq] * s * gv.x, acc[fb][tb][4 * gq + 1] * s * gv.y);
                w.y = pk(acc[fb][tb][4 * gq + 2] * s * gv.z, acc[fb][tb][4 * gq + 3] * s * gv.w);
                *(u32x2*)(dst + 32 * fb + 8 * gq) = w;
            }
        const float* rp = p.rope + pos * 32;
#pragma unroll
        for (int gq = 0; gq < 2; ++gq) {
            const int i0 = 8 * gq + 4 * hh;
            const f32x4 c4 = *(const f32x4*)(rp + i0), s4 = *(const f32x4*)(rp + 16 + i0);
            const f32x4 g1 = *(const f32x4*)(g + 64 + i0), g2 = *(const f32x4*)(g + 80 + i0);
            float o1[4], o2[4];
#pragma unroll
            for (int i = 0; i < 4; ++i) {
                const float x1 = acc[2][tb][4 * gq + i] * rn * g1[i] * QS, x2 = acc[2][tb][4 * gq + i + 8] * rn * g2[i] * QS;
                o1[i] = x1 * c4[i] - x2 * s4[i]; o2[i] = x1 * s4[i] + x2 * c4[i];
            }
            u32x2 w1, w2; w1.x = pk(o1[0], o1[1]); w1.y = pk(o1[2], o1[3]); w2.x = pk(o2[0], o2[1]); w2.y = pk(o2[2], o2[3]);
            *(u32x2*)(dst + 64 + 8 * gq) = w1;
            *(u32x2*)(dst + 80 + 8 * gq) = w2;
        }
    }
}

DI void epi_kv(const Params& p, int layer, f32x16 (&acc)[4][2], int tok0, int head) {
    __builtin_amdgcn_sched_barrier(0);
    const int lane = otid() & 63, wave = otid() >> 6, l31 = lane & 31, hh = lane >> 5;
    const float* g = p.qk_k_g + layer * 96;
#pragma unroll
    for (int tb = 0; tb < 2; ++tb) {
        const int t = tok0 + wave * 64 + tb * 32 + l31, pos = t & (SEQ - 1), bidx = t >> 13;
        const float rc = rsqrtf((p.ss_p[t * 8 + 6] + p.ss_p[t * 8 + 7]) * (1.0f / 256.0f) + EPS);
        const int pp = (pos & ~15) | ((pos & 4) << 1) | ((pos & 8) >> 1) | (pos & 3);
        char* vbase = (char*)(p.VT + (size_t)((tok0 >> 13) * 8 + head) * 64 * SEQ);
        const unsigned voff = (unsigned)(4 * hh * SEQ + pp) * 2u;
#pragma unroll
        for (int fb = 2; fb < 4; ++fb)
#pragma unroll
            for (int r = 0; r < 16; ++r) {
                const int dvc = 32 * (fb - 2) + (r & 3) + 8 * (r >> 2);
                *(bf16_t*)(vbase + (size_t)dvc * SEQ * 2 + voff) = (bf16_t)(pk(acc[fb][tb][r] * rc, 0.f) & 0xffffu);
            }
        asm volatile("" ::: "memory");
        const bf16_t* kr = p.proj + (size_t)t * NIN + C_KR + 8 * hh;
        const u32x4 ka = *(const u32x4*)kr, kb = *(const u32x4*)(kr + 16);
        float x1[8], x2[8];
#pragma unroll
        for (int i = 0; i < 4; ++i) { x1[2 * i] = bflo(ka[i]); x1[2 * i + 1] = bfhi(ka[i]); x2[2 * i] = bflo(kb[i]); x2[2 * i + 1] = bfhi(kb[i]); }
        float ss = 0.f, sr = 0.f;
#pragma unroll
        for (int i = 0; i < 8; ++i) sr += x1[i] * x1[i] + x2[i] * x2[i];
#pragma unroll
        for (int fb = 0; fb < 2; ++fb)
#pragma unroll
            for (int r = 0; r < 16; ++r) ss += acc[fb][tb][r] * acc[fb][tb][r];
        ss = ss * rc * rc + sr;
        ss += __shfl_xor(ss, 32);
        const float rn = rsqrtf(ss * (1.0f / 96.0f) + EPS);
        const float rk = rn * rc;
        bf16_t* kd = p.K + ((size_t)(bidx * 8 + head) * SEQ + pos) * 96;
#pragma unroll
        for (int fb = 0; fb < 2; ++fb)
#pragma unroll
            for (int gq = 0; gq < 4; ++gq) {
                const int f = 32 * fb + 8 * gq + 4 * hh;
                const f32x4 gv = *(const f32x4*)(g + f);
                u32x2 w; w.x = pk(acc[fb][tb][4 * gq] * rk * gv.x, acc[fb][tb][4 * gq + 1] * rk * gv.y);
                w.y = pk(acc[fb][tb][4 * gq + 2] * rk * gv.z, acc[fb][tb][4 * gq + 3] * rk * gv.w);
                *(u32x2*)(kd + f) = w;
            }
        {
            const float* rp = p.rope + pos * 32 + 8 * hh;
            float o1[8], o2[8];
#pragma unroll
            for (int q4 = 0; q4 < 2; ++q4) {
                const f32x4 c4 = *(const f32x4*)(rp + 4 * q4), s4 = *(const f32x4*)(rp + 16 + 4 * q4);
                const f32x4 g1 = *(const f32x4*)(g + 64 + 8 * hh + 4 * q4), g2 = *(const f32x4*)(g + 80 + 8 * hh + 4 * q4);
#pragma unroll
                for (int i = 0; i < 4; ++i) {
                    const float a = x1[4 * q4 + i] * rn * g1[i], b = x2[4 * q4 + i] * rn * g2[i];
                    o1[4 * q4 + i] = a * c4[i] - b * s4[i]; o2[4 * q4 + i] = a * s4[i] + b * c4[i];
                }
            }
            u32x4 w1, w2;
            w1.x = pk(o1[0], o1[1]); w1.y = pk(o1[2], o1[3]); w1.z = pk(o1[4], o1[5]); w1.w = pk(o1[6], o1[7]);
            w2.x = pk(o2[0], o2[1]); w2.y = pk(o2[2], o2[3]); w2.z = pk(o2[4], o2[5]); w2.w = pk(o2[6], o2[7]);
            *(u32x4*)(kd + 64 + 8 * hh) = w1;
            *(u32x4*)(kd + 80 + 8 * hh) = w2;
        }
    }
}

DI void conv_item(const Params& p, int layer, int ct, char* lds) {
    const int tid = otid(), lane = tid & 63, wave = tid >> 6, l31 = lane & 31, hh = lane >> 5;
    constexpr int CR = 528;
    const int t0 = ct * 64, pos0 = t0 & (SEQ - 1);
    __syncthreads();
#pragma unroll 1
    for (int c0 = tid; c0 < 94 * 32; c0 += 1024) {
        u32x4 a[4], g[4];
#pragma unroll
        for (int u = 0; u < 4; ++u) {
            const int c = c0 + 256 * u, i = c >> 5, ch = c & 31;
            a[u] = (u32x4){0u, 0u, 0u, 0u}; g[u] = a[u];
            if (c < 94 * 32 && pos0 - 30 + i >= 0) {
                const bf16_t* src = p.proj + (size_t)(t0 - 30 + i) * NIN + 8 * ch;
                a[u] = *(const u32x4*)(src + C_A); g[u] = *(const u32x4*)(src + C_AG);
            }
        }
#pragma unroll
        for (int u = 0; u < 4; ++u) {
            const int c = c0 + 256 * u, i = c >> 5, ch = c & 31;
            if (c < 94 * 32) {
                u32x4 w;
#pragma unroll
                for (int e = 0; e < 4; ++e) w[e] = pk(bflo(a[u][e]) * sigmoidf_(bflo(g[u][e])), bfhi(a[u][e]) * sigmoidf_(bfhi(g[u][e])));
                *(u32x4*)(lds + i * CR + ch * 16) = w;
            }
        }
    }
    __syncthreads();
    {
        float w[31];
        const char* cw = (const char*)(p.conv_w + (size_t)layer * 31 * 256);
        const unsigned cwo = (unsigned)tid * 4u;
#pragma unroll
        for (int k = 0; k < 31; ++k) w[k] = *(const float*)(cw + k * 1024 + cwo);
        const float cb = p.conv_b[layer * 256 + tid];
#pragma unroll 1
        for (int tg = 0; tg < 8; ++tg) {
            float in[38];
            const char* base = lds + (8 * tg) * CR + 2 * tid;
#pragma unroll
            for (int i = 0; i < 38; ++i) in[i] = __uint_as_float((unsigned)(*(const bf16_t*)(base + i * CR)) << 16);
#pragma unroll
            for (int j = 0; j < 8; ++j) {
                float o = cb;
#pragma unroll
                for (int k = 0; k < 31; ++k) o += w[k] * in[j + k];
                *(bf16_t*)(lds + (8 * tg + j) * CR + 2 * tid) = (bf16_t)(pk(o, 0.f) & 0xffffu);
            }
        }
    }
    __syncthreads();
    {
        const int tok = tid >> 2, part = tid & 3;
        char* base = lds + tok * CR + part * 128;
        float v[64];
#pragma unroll
        for (int i = 0; i < 8; ++i) {
            const u32x4 w = *(const u32x4*)(base + 16 * i);
#pragma unroll
            for (int e = 0; e < 4; ++e) { v[8 * i + 2 * e] = bflo(w[e]); v[8 * i + 2 * e + 1] = bfhi(w[e]); }
        }
        float s = 0.f;
#pragma unroll
        for (int i = 0; i < 64; ++i) s += v[i];
        s += __shfl_xor(s, 1); s += __shfl_xor(s, 2);
        const float mu = s * (1.0f / 256.0f);
        float q = 0.f;
#pragma unroll
        for (int i = 0; i < 64; ++i) { const float d = v[i] - mu; q += d * d; }
        q += __shfl_xor(q, 1); q += __shfl_xor(q, 2);
        const float rs = rsqrtf(q * (1.0f / 256.0f) + EPS);
        const float* lg = p.conv_ln_g + layer * 256 + part * 64;
        const float* lb = p.conv_ln_b + layer * 256 + part * 64;
#pragma unroll
        for (int i = 0; i < 8; ++i) {
            const f32x4 g0 = *(const f32x4*)(lg + 8 * i), g1 = *(const f32x4*)(lg + 8 * i + 4);
            const f32x4 b0 = *(const f32x4*)(lb + 8 * i), b1 = *(const f32x4*)(lb + 8 * i + 4);
            float y[8];
#pragma unroll
            for (int e = 0; e < 4; ++e) { y[e] = siluf_((v[8 * i + e] - mu) * rs * g0[e] + b0[e]); y[4 + e] = siluf_((v[8 * i + 4 + e] - mu) * rs * g1[e] + b1[e]); }
            u32x4 w; w.x = pk(y[0], y[1]); w.y = pk(y[2], y[3]); w.z = pk(y[4], y[5]); w.w = pk(y[6], y[7]);
            *(u32x4*)(base + 16 * i) = w;
        }
    }
    __syncthreads();
    f32x16 acc[2][2]; zero_acc(acc);
    {
        const bf16_t* wsrc = p.PwT + (size_t)layer * 256 * 256 + (size_t)(64 * wave + l31) * 256 + 8 * hh;
        const char* tfp = lds + l31 * CR + hh * 16;
#pragma unroll 8
        for (int s = 0; s < 16; ++s) {
            bf16x8 wf[2], tf[2];
#pragma unroll
            for (int fb = 0; fb < 2; ++fb) wf[fb] = *(const bf16x8*)(wsrc + fb * 32 * 256 + 16 * s);
#pragma unroll
            for (int tb = 0; tb < 2; ++tb) tf[tb] = *(const bf16x8*)(tfp + tb * 32 * CR + s * 32);
#pragma unroll
            for (int fb = 0; fb < 2; ++fb)
#pragma unroll
                for (int tb = 0; tb < 2; ++tb) acc[fb][tb] = mfma(wf[fb], tf[tb], acc[fb][tb]);
        }
    }
    float* red = (float*)(lds + 49664);
    float ss[2] = {0.f, 0.f};
#pragma unroll
    for (int tb = 0; tb < 2; ++tb) {
        const int t = t0 + 32 * tb + l31;
#pragma unroll
        for (int fb = 0; fb < 2; ++fb)
#pragma unroll
            for (int gq = 0; gq < 4; ++gq) {
                const int f = 64 * wave + 32 * fb + 8 * gq + 4 * hh;
                const f32x4 bv = *(const f32x4*)(p.conv_pw_b + layer * 256 + f);
                const u32x2 z = *(const u32x2*)(p.proj + (size_t)t * NIN + C_ZC + f);
                const float v0 = (acc[fb][tb][4 * gq] + bv.x) * siluf_(bflo(z.x)), v1 = (acc[fb][tb][4 * gq + 1] + bv.y) * siluf_(bfhi(z.x));
                const float v2 = (acc[fb][tb][4 * gq + 2] + bv.z) * siluf_(bflo(z.y)), v3 = (acc[fb][tb][4 * gq + 3] + bv.w) * siluf_(bfhi(z.y));
                acc[fb][tb][4 * gq] = v0; acc[fb][tb][4 * gq + 1] = v1; acc[fb][tb][4 * gq + 2] = v2; acc[fb][tb][4 * gq + 3] = v3;
                ss[tb] += v0 * v0 + v1 * v1 + v2 * v2 + v3 * v3;
            }
        ss[tb] += __shfl_xor(ss[tb], 32);
        if (hh == 0) red[wave * 64 + 32 * tb + l31] = ss[tb];
    }
    __syncthreads();
#pragma unroll
    for (int tb = 0; tb < 2; ++tb) {
        const int t = t0 + 32 * tb + l31, ti = 32 * tb + l31;
        const float tot = (red[ti] + red[64 + ti]) + (red[128 + ti] + red[192 + ti]);
        const float rn = rsqrtf(tot * (1.0f / 256.0f) + EPS);
#pragma unroll
        for (int fb = 0; fb < 2; ++fb)
#pragma unroll
            for (int gq = 0; gq < 4; ++gq) {
                const int f = 64 * wave + 32 * fb + 8 * gq + 4 * hh;
                u32x2 w; w.x = pk(acc[fb][tb][4 * gq] * rn, acc[fb][tb][4 * gq + 1] * rn); w.y = pk(acc[fb][tb][4 * gq + 2] * rn, acc[fb][tb][4 * gq + 3] * rn);
                *(u32x2*)(p.Y + (size_t)t * 1024 + 768 + f) = w;
            }
    }
}

DI void sgu_item(const Params& p, int layer, int ch, char* lds) {
    const int tid = otid(), lane = tid & 63, wave = tid >> 6, l31 = lane & 31, hh = lane >> 5;
    constexpr int VR = 272;
    const int t0 = ch * 128;
    __syncthreads();
#pragma unroll 1
    for (int hf = 0; hf < 2; ++hf) {
        const int tok = 64 * hf + (tid >> 2), part = tid & 3;
        const bf16_t* src = p.proj + (size_t)(t0 + tok) * NIN + C_V;
        float v[64];
#pragma unroll
        for (int i = 0; i < 8; ++i) {
            const u32x4 w = *(const u32x4*)(src + 8 * (4 * i + part));
#pragma unroll
            for (int e = 0; e < 4; ++e) { v[8 * i + 2 * e] = geluf_(bflo(w[e])); v[8 * i + 2 * e + 1] = geluf_(bfhi(w[e])); }
        }
        float s = 0.f;
#pragma unroll
        for (int i = 0; i < 64; ++i) s += v[i];
        s += __shfl_xor(s, 1); s += __shfl_xor(s, 2);
        const float mu = s * (1.0f / 256.0f);
        float q = 0.f;
#pragma unroll
        for (int i = 0; i < 64; ++i) { const float d = v[i] - mu; q += d * d; }
        q += __shfl_xor(q, 1); q += __shfl_xor(q, 2);
        const float rs = rsqrtf(q * (1.0f / 256.0f) + EPS);
#pragma unroll
        for (int i = 0; i < 8; ++i) {
            const int c0 = 8 * (4 * i + part);
            const float* lg = p.sg_ln_g + layer * 256 + c0;
            const float* lb = p.sg_ln_b + layer * 256 + c0;
            const f32x4 g0 = *(const f32x4*)lg, g1 = *(const f32x4*)(lg + 4), b0 = *(const f32x4*)lb, b1 = *(const f32x4*)(lb + 4);
#pragma unroll
            for (int e = 0; e < 4; ++e) {
                const float y0 = (v[8 * i + e] - mu) * rs * g0[e] + b0[e], y1 = (v[8 * i + 4 + e] - mu) * rs * g1[e] + b1[e];
                *(bf16_t*)(lds + (c0 + e) * VR + tok * 2) = (bf16_t)(pk(y0, 0.f) & 0xffffu);
                *(bf16_t*)(lds + (c0 + 4 + e) * VR + tok * 2) = (bf16_t)(pk(y1, 0.f) & 0xffffu);
            }
        }
    }
    __syncthreads();
    const int tch = 32 * wave + l31, t = t0 + tch;
    float ss = 0.f;
#pragma unroll 1
    for (int hp = 0; hp < 2; ++hp) {
        f32x16 acc[4][1]; zero_acc(acc);
        const bf16_t* wsrc = p.SgW + ((size_t)(layer * 4 + 2 * hp) * 128 + 32 * wave + l31) * 128 + 8 * hh;
        const char* afp = lds + (128 * hp + l31) * VR + hh * 16;
        const int nsteps = 2 * (wave + 1);
        bf16x8 bfr[2][8];
#pragma unroll
        for (int s = 0; s < 8; ++s)
#pragma unroll
            for (int g = 0; g < 2; ++g) bfr[g][s] = (s < nsteps) ? *(const bf16x8*)(wsrc + (size_t)g * 128 * 128 + 16 * s) : (bf16x8){0, 0, 0, 0, 0, 0, 0, 0};
#pragma unroll
        for (int s = 0; s < 8; ++s) {
            if (s < nsteps) {
#pragma unroll
                for (int g = 0; g < 2; ++g)
#pragma unroll
                    for (int e = 0; e < 2; ++e) {
                        const int fb = 2 * g + e;
                        const bf16x8 afr = *(const bf16x8*)(afp + fb * 32 * VR + s * 32);
                        acc[fb][0] = mfma(afr, bfr[g][s], acc[fb][0]);
                    }
            }
        }
#pragma unroll
        for (int fb = 0; fb < 4; ++fb) {
            const float bias = p.sg_b[(layer * 4 + 2 * hp + (fb >> 1)) * 128 + tch];
#pragma unroll
            for (int gq = 0; gq < 4; ++gq) {
                const int f = 128 * hp + 32 * fb + 8 * gq + 4 * hh;
                const u32x2 u = *(const u32x2*)(p.proj + (size_t)t * NIN + C_U + f);
                const u32x2 z = *(const u32x2*)(p.proj + (size_t)t * NIN + C_ZS + f);
                const float v0 = geluf_(bflo(u.x)) * (acc[fb][0][4 * gq] + bias) * siluf_(bflo(z.x));
                const float v1 = geluf_(bfhi(u.x)) * (acc[fb][0][4 * gq + 1] + bias) * siluf_(bfhi(z.x));
                const float v2 = geluf_(bflo(u.y)) * (acc[fb][0][4 * gq + 2] + bias) * siluf_(bflo(z.y));
                const float v3 = geluf_(bfhi(u.y)) * (acc[fb][0][4 * gq + 3] + bias) * siluf_(bfhi(z.y));
                ss += v0 * v0 + v1 * v1 + v2 * v2 + v3 * v3;
                u32x2 w; w.x = pk(v0, v1); w.y = pk(v2, v3);
                *(u32x2*)(p.Y + (size_t)t * 1024 + 512 + f) = w;
            }
        }
    }
    (void)ss;
}

DI void phase_pre(const Params& p, int layer, char* lds) {
    for (int item = blockIdx.x; item < 512; item += gridDim.x) {
        const int x = item & 7, j = item >> 3, tt = 8 * x + (j >> 3), head = j & 7;
        f32x16 acc[3][2]; zero_acc(acc);
        gemm_tile<3, 2>(p.WuqT + (size_t)layer * 768 * 768 + (size_t)head * 96 * 768, 768, p.proj + (size_t)tt * 256 * NIN + C_CQ, NIN, 768, lds, acc);
        epi_q(p, layer, acc, tt * 256, head);
    }
    for (int item = blockIdx.x; item < 512; item += gridDim.x) {
        const int x = item & 7, j = item >> 3, tt = 8 * x + (j >> 3), head = j & 7;
        f32x16 acc[4][2]; zero_acc(acc);
        gemm_tile<4, 2>(p.WukvT + (size_t)layer * 1024 * 256 + (size_t)head * 128 * 256, 256, p.proj + (size_t)tt * 256 * NIN + C_CKV, NIN, 256, lds, acc);
        epi_kv(p, layer, acc, tt * 256, head);
    }
}

template <bool FIXED>
DI void attn_qtile(const Params& p, int bh, int qt, char* lds) {
    const int tid = otid(), lane = tid & 63, wave = tid >> 6, l31 = lane & 31, hh = lane >> 5;
    constexpr int KR = 208, KB = 64 * KR, VB = 64 * LROW, VOFF = 2 * KB;
    const int q0w = qt * 128 + 32 * wave;
    const bf16_t* Kg = p.K + (size_t)bh * SEQ * 96;
    const bf16_t* Vg = p.VT + (size_t)bh * 64 * SEQ;
    bf16x8 qf[6];
    {
        const bf16_t* qp = p.Q + ((size_t)bh * SEQ + q0w + l31) * 96 + 8 * hh;
#pragma unroll
        for (int s = 0; s < 6; ++s) qf[s] = *(const bf16x8*)(qp + 16 * s);
    }
    f32x16 O[2];
#pragma unroll
    for (int d = 0; d < 2; ++d)
#pragma unroll
        for (int r = 0; r < 16; ++r) O[d][r] = 0.f;
    float m = -1e30f, l = 0.f;
    const int ntiles = 2 * qt + 2;
    u32x4 kreg[3], vreg[2];
    const int vdv = tid >> 3, vkc = tid & 7;
#define ATT_GLOAD(j) { \
        _Pragma("unroll") for (int i = 0; i < 3; ++i) kreg[i] = *(const u32x4*)(Kg + (size_t)(j) * 64 * 96 + (tid + 256 * i) * 8); \
        _Pragma("unroll") for (int i = 0; i < 2; ++i) vreg[i] = *(const u32x4*)(Vg + (size_t)(vdv + 32 * i) * SEQ + (j) * 64 + vkc * 8); }
#define ATT_LSTORE(buf) { \
        _Pragma("unroll") for (int i = 0; i < 3; ++i) { const int c = tid + 256 * i; *(u32x4*)(lds + (buf) * KB + (c / 12) * KR + (c % 12) * 16) = kreg[i]; } \
        _Pragma("unroll") for (int i = 0; i < 2; ++i) *(u32x4*)(lds + VOFF + (buf) * VB + (vdv + 32 * i) * LROW + vkc * 16) = vreg[i]; }
    __syncthreads();
    ATT_GLOAD(0);
    ATT_LSTORE(0);
    if (ntiles > 1) ATT_GLOAD(1);
    __syncthreads();
    for (int j = 0; j < ntiles; ++j) {
        const int kv0 = 64 * j;
        if (kv0 <= q0w + 31) {
            const char* Kb = lds + (j & 1) * KB + l31 * KR + hh * 16;
            const char* Vb = lds + VOFF + (j & 1) * VB + l31 * LROW + hh * 16;
            f32x16 sc[2];
            bf16x8 kf[2][6], vf[2][4];
#pragma unroll
            for (int kb = 0; kb < 2; ++kb)
#pragma unroll
                for (int s = 0; s < 6; ++s) kf[kb][s] = *(const bf16x8*)(Kb + kb * 32 * KR + s * 32);
            __builtin_amdgcn_sched_barrier(0);
#pragma unroll
            for (int kb = 0; kb < 2; ++kb)
#pragma unroll
                for (int r = 0; r < 16; ++r) sc[kb][r] = 0.f;
#pragma unroll
            for (int s = 0; s < 6; ++s)
#pragma unroll
                for (int kb = 0; kb < 2; ++kb) sc[kb] = mfma(kf[kb][s], qf[s], sc[kb]);
#pragma unroll
            for (int d = 0; d < 2; ++d)
#pragma unroll
                for (int ks = 0; ks < 4; ++ks) vf[d][ks] = *(const bf16x8*)(Vb + d * 32 * LROW + ks * 32);
            __builtin_amdgcn_sched_barrier(0);
            if (kv0 + 63 > q0w) {
                const int qi = q0w + l31;
#pragma unroll
                for (int kb = 0; kb < 2; ++kb)
#pragma unroll
                    for (int r = 0; r < 16; ++r) { const int key = kv0 + 32 * kb + crow(r, hh); if (key > qi) sc[kb][r] = -1e30f; }
            }
            if (FIXED) {
                f32x2 rs2 = {0.f, 0.f};
#pragma unroll
                for (int kb = 0; kb < 2; ++kb)
#pragma unroll
                    for (int r = 0; r < 16; r += 2) { const float p0 = fexp2(sc[kb][r]), p1 = fexp2(sc[kb][r + 1]); sc[kb][r] = p0; sc[kb][r + 1] = p1; rs2 += (f32x2){p0, p1}; }
                l += rs2.x + rs2.y;
            } else {
            float mx = -1e30f;
#pragma unroll
            for (int kb = 0; kb < 2; ++kb)
#pragma unroll
                for (int r = 0; r < 16; ++r) mx = fmaxf(mx, sc[kb][r]);
            mx = fmaxf(mx, __shfl_xor(mx, 32));
            const float mn = fmaxf(m, mx), alpha = fexp2(m - mn);
            m = mn;
            float rsum = 0.f;
#pragma unroll
            for (int kb = 0; kb < 2; ++kb)
#pragma unroll
                for (int r = 0; r < 16; ++r) { const float pv = fexp2(sc[kb][r] - mn); sc[kb][r] = pv; rsum += pv; }
            l = l * alpha + rsum;
#pragma unroll
            for (int d = 0; d < 2; ++d)
#pragma unroll
                for (int r = 0; r < 16; ++r) O[d][r] *= alpha;
            }
#pragma unroll
            for (int kb = 0; kb < 2; ++kb)
#pragma unroll
                for (int sp = 0; sp < 2; ++sp) {
                    u32x4 w;
                    w.x = pk(sc[kb][8 * sp], sc[kb][8 * sp + 1]); w.y = pk(sc[kb][8 * sp + 2], sc[kb][8 * sp + 3]);
                    w.z = pk(sc[kb][8 * sp + 4], sc[kb][8 * sp + 5]); w.w = pk(sc[kb][8 * sp + 6], sc[kb][8 * sp + 7]);
                    const bf16x8 pf = __builtin_bit_cast(bf16x8, w);
#pragma unroll
                    for (int d = 0; d < 2; ++d) O[d] = mfma(vf[d][2 * kb + sp], pf, O[d]);
                }
        }
        if (j + 1 < ntiles) {
            ATT_LSTORE((j + 1) & 1);
            if (j + 2 < ntiles) ATT_GLOAD(j + 2);
        }
        __syncthreads();
    }
#undef ATT_GLOAD
#undef ATT_LSTORE
    l += __shfl_xor(l, 32);
    const float inv = 1.0f / l;
    const int head = bh & 7, bidx = bh >> 3;
    const int t = bidx * SEQ + q0w + l31;
    float ss = 0.f;
#pragma unroll
    for (int d = 0; d < 2; ++d)
#pragma unroll
        for (int gq = 0; gq < 4; ++gq) {
            const int dv = 32 * d + 8 * gq + 4 * hh;
            const u32x2 z = *(const u32x2*)(p.proj + (size_t)t * NIN + C_ZM + head * 64 + dv);
            const float v0 = O[d][4 * gq] * inv * siluf_(bflo(z.x)), v1 = O[d][4 * gq + 1] * inv * siluf_(bfhi(z.x));
            const float v2 = O[d][4 * gq + 2] * inv * siluf_(bflo(z.y)), v3 = O[d][4 * gq + 3] * inv * siluf_(bfhi(z.y));
            ss += v0 * v0 + v1 * v1 + v2 * v2 + v3 * v3;
            u32x2 w; w.x = pk(v0, v1); w.y = pk(v2, v3);
            *(u32x2*)(p.Y + (size_t)t * 1024 + head * 64 + dv) = w;
        }
    (void)ss;
}

DI void phase_attn(const Params& p, int layer, char* lds) {
    float gq = 0.f, gk = 0.f;
    for (int i = 0; i < 96; ++i) { gq = fmaxf(gq, fabsf(p.qk_q_g[layer * 96 + i])); gk = fmaxf(gk, fabsf(p.qk_k_g[layer * 96 + i])); }
    const bool fixed_ok = 96.0f * gq * gk * (0.10206207261596577f * 1.4426950408889634f) < 40.0f;
    for (int item = blockIdx.x; item < 256; item += gridDim.x) conv_item(p, layer, item, lds);
    for (int item = blockIdx.x; item < 512; item += gridDim.x) {
        const int bh = 2 * (item & 7) + (item >> 8), i = (item >> 3) & 31;
        if (fixed_ok) { attn_qtile<true>(p, bh, 63 - i, lds); attn_qtile<true>(p, bh, i, lds); }
        else { attn_qtile<false>(p, bh, 63 - i, lds); attn_qtile<false>(p, bh, i, lds); }
    }
    for (int item = gridDim.x - 1 - blockIdx.x; item < 128; item += gridDim.x) sgu_item(p, layer, item, lds);
}

DI void phase_norm(const Params& p) {
    const int lane = threadIdx.x & 63, wave = threadIdx.x >> 6;
    for (int t0 = (blockIdx.x * 4 + wave) * 4; t0 < NT; t0 += gridDim.x * 16) {
        u32x4 m[4]; u32x2 g[4];
#pragma unroll
        for (int r = 0; r < 4; ++r) { const bf16_t* row = p.Y + (size_t)(t0 + r) * 1024; m[r] = *(const u32x4*)(row + 8 * lane); g[r] = *(const u32x2*)(row + 512 + 4 * lane); }
        float sm[4], sg[4];
#pragma unroll
        for (int r = 0; r < 4; ++r) {
            sm[r] = 0.f; sg[r] = 0.f;
#pragma unroll
            for (int e = 0; e < 4; ++e) { const float a = bflo(m[r][e]), b = bfhi(m[r][e]); sm[r] += a * a + b * b; }
#pragma unroll
            for (int e = 0; e < 2; ++e) { const float a = bflo(g[r][e]), b = bfhi(g[r][e]); sg[r] += a * a + b * b; }
        }
#pragma unroll
        for (int o = 32; o >= 1; o >>= 1)
#pragma unroll
            for (int r = 0; r < 4; ++r) { sm[r] += __shfl_xor(sm[r], o); sg[r] += __shfl_xor(sg[r], o); }
#pragma unroll
        for (int r = 0; r < 4; ++r) {
            const float rm = rsqrtf(sm[r] * (1.0f / 512.0f) + EPS), rg = rsqrtf(sg[r] * (1.0f / 256.0f) + EPS);
            u32x4 mo; u32x2 go;
#pragma unroll
            for (int e = 0; e < 4; ++e) mo[e] = pk(bflo(m[r][e]) * rm, bfhi(m[r][e]) * rm);
#pragma unroll
            for (int e = 0; e < 2; ++e) go[e] = pk(bflo(g[r][e]) * rg, bfhi(g[r][e]) * rg);
            bf16_t* row = p.Y + (size_t)(t0 + r) * 1024;
            *(u32x4*)(row + 8 * lane) = mo;
            *(u32x2*)(row + 512 + 4 * lane) = go;
        }
    }
}

DI void phase_out(const Params& p, int layer, char* lds) {
    const int lane = otid() & 63, wave = otid() >> 6, l31 = lane & 31, hh = lane >> 5;
    const float* xin = layer == 0 ? p.x : p.out;
    const bf16_t* W = p.WoutT + (size_t)layer * 1024 * 1024;
    for (int item = blockIdx.x; item < 512; item += gridDim.x) {
        const int x = item & 7, j = item >> 3, tt = 8 * x + (j >> 3), ft = j & 7;
        f32x16 acc[4][2]; zero_acc(acc);
        const bf16_t* Wt = W + (size_t)ft * 128 * 1024;
        const bf16_t* Yt = p.Y + (size_t)tt * 256 * 1024;
        gemm_tile<4, 2>(Wt, 1024, Yt, 1024, 1024, lds, acc);
        {
            char* wl = lds + wave * (32 * 528);
            const int c = lane & 31, rh = lane >> 5;
            __syncthreads();
#pragma unroll
            for (int tb = 0; tb < 2; ++tb) {
                const int tw = tt * 256 + wave * 64 + tb * 32;
#pragma unroll
                for (int fb = 0; fb < 4; ++fb)
#pragma unroll
                    for (int gq = 0; gq < 4; ++gq) {
                        f32x4 v; v.x = acc[fb][tb][4 * gq]; v.y = acc[fb][tb][4 * gq + 1]; v.z = acc[fb][tb][4 * gq + 2]; v.w = acc[fb][tb][4 * gq + 3];
                        *(f32x4*)(wl + l31 * 528 + (32 * fb + 8 * gq + 4 * hh) * 4) = v;
                    }
#pragma unroll 4
                for (int i = 0; i < 16; ++i) {
                    const int row = 2 * i + rh, t = tw + row, f = ft * 128 + 4 * c;
                    const f32x4 v = *(const f32x4*)(wl + row * 528 + c * 16);
                    f32x4 xv = *(const f32x4*)(xin + (size_t)t * 1024 + f);
                    xv.x += v.x; xv.y += v.y; xv.z += v.z; xv.w += v.w;
                    *(f32x4*)(p.out + (size_t)t * 1024 + f) = xv;
                    if (layer == 0) {
                        u32x2 w; w.x = pk(xv.x, xv.y); w.y = pk(xv.z, xv.w);
                        *(u32x2*)(p.xb + (size_t)t * 1024 + f) = w;
                        float ss = xv.x * xv.x + xv.y * xv.y + xv.z * xv.z + xv.w * xv.w;
                        ss += __shfl_xor(ss, 16); ss += __shfl_xor(ss, 8); ss += __shfl_xor(ss, 4); ss += __shfl_xor(ss, 2); ss += __shfl_xor(ss, 1);
                        if (c == 0) p.ss_x[t * 8 + ft] = ss;
                    }
                }
            }
        }
    }
}


#define XB_TMO      128
#define XB_XCNT(j)  (256  + 64 * (j))
#define XB_XSUB(j)  (1280 + 64 * (j))
#define XB_XGEN(j)  (2304 + 64 * (j))
#define XB_TOP      3328
#define XB_TOPGEN   3392
#define XCD_BAR_WORDS 3456
#define XB_SPIN_CAP (1u << 20)
#define LAS __attribute__((address_space(3)))
DI unsigned xb_ld(unsigned* p)              { return __hip_atomic_load(p, __ATOMIC_RELAXED, __HIP_MEMORY_SCOPE_AGENT); }
DI unsigned xb_add(unsigned* p, unsigned v) { return __hip_atomic_fetch_add(p, v, __ATOMIC_RELAXED, __HIP_MEMORY_SCOPE_AGENT); }
DI unsigned xb_xcc_id() { return (unsigned)__builtin_amdgcn_s_getreg((3 << 11) | 20) & 0xFu; }
#define XB_SPIN(cond, bar) do { unsigned _sp = 0; while (cond) { __builtin_amdgcn_s_sleep(1); \
    if ((++_sp & 255u) == 0u) { if (xb_ld(&(bar)[XB_TMO])) break; if (_sp > XB_SPIN_CAP) { atomicAdd(&(bar)[XB_TMO], 1u); break; } } } } while (0)
struct XcdBarrier { unsigned* bar; unsigned x; volatile LAS unsigned* st; };
DI XcdBarrier xcd_barrier_post(unsigned* bar, volatile LAS unsigned* st) {
    XcdBarrier b; b.bar = bar; b.x = xb_xcc_id(); b.st = st;
    if (threadIdx.x == 0) (void)xb_add(&bar[XB_XCNT(b.x)], 1u);
    return b;
}
DI void xcd_barrier_complete(unsigned* bar, unsigned x, unsigned& nloc, unsigned& nx) {
    const unsigned G = gridDim.x * gridDim.y * gridDim.z;
    unsigned sum, cnt, mine, sp = 0u;
    for (;;) {
        sum = 0u; cnt = 0u; mine = 0u;
#pragma unroll
        for (unsigned j = 0; j < 16; ++j) { const unsigned c = xb_ld(&bar[XB_XCNT(j)]); sum += c; cnt += (c > 0u) ? 1u : 0u; mine = (j == x) ? c : mine; }
        if (sum == G) break;
        __builtin_amdgcn_s_sleep(1);
        if ((++sp & 255u) == 0u) { if (xb_ld(&bar[XB_TMO])) break; if (sp > XB_SPIN_CAP) { atomicAdd(&bar[XB_TMO], 1u); break; } }
    }
    nloc = mine > 0u ? mine : 1u; nx = cnt > 0u ? cnt : 1u;
}
DI void xcd_barrier(const XcdBarrier& b) {
    asm volatile("s_waitcnt vmcnt(0)" ::: "memory");
    __syncthreads();
    if (threadIdx.x == 0) {
        unsigned* bar = b.bar;
        __builtin_amdgcn_s_waitcnt(0);
        unsigned nloc = b.st[0], nx = b.st[1];
        if (nloc == 0u) { xcd_barrier_complete(bar, b.x, nloc, nx); b.st[0] = nloc; b.st[1] = nx; }
        const unsigned old = xb_add(&bar[XB_XSUB(b.x)], 1u);
        const unsigned gen = old / nloc;
        if (old + 1u == (gen + 1u) * nloc) {
            __builtin_amdgcn_fence(__ATOMIC_RELEASE, "agent");
            asm volatile("s_waitcnt vmcnt(0)" ::: "memory");
            const unsigned og = xb_add(&bar[XB_TOP], 1u);
            const unsigned tg = og / nx;
            if (og + 1u == (tg + 1u) * nx) xb_add(&bar[XB_TOPGEN], 1u);
            else XB_SPIN(xb_ld(&bar[XB_TOPGEN]) == tg, bar);
            __builtin_amdgcn_fence(__ATOMIC_ACQUIRE, "agent");
            xb_add(&bar[XB_XGEN(b.x)], 1u);
            asm volatile("s_waitcnt vmcnt(0)" ::: "memory");
        } else {
            XB_SPIN(xb_ld(&bar[XB_XGEN(b.x)]) == gen, bar);
            __builtin_amdgcn_fence(__ATOMIC_ACQUIRE, "agent");
            asm volatile("s_waitcnt vmcnt(0)" ::: "memory");
        }
    }
    __syncthreads();
}
#if MK_LAUNCHES == 1
DI void gsync() {
    asm volatile("s_waitcnt vmcnt(0)" ::: "memory");
    cg::this_grid().sync();
}
__global__ void __launch_bounds__(256, 2) mega_kernel(Params p) {
    __shared__ __attribute__((aligned(16))) char lds[LDS_BYTES];
    __shared__ uint4 xb_words;
    if (threadIdx.x == 0) xb_words = make_uint4(0u, 0u, 0u, 0u);
    __syncthreads();
    for (int i = blockIdx.x * 256 + threadIdx.x; i < XCD_BAR_WORDS + 64; i += gridDim.x * 256) p.bar[i] = 0u;
    gsync();
    if (threadIdx.x == 0) (void)xb_add(&p.bar[XB_XCNT(xb_xcc_id())], 1u);
    phase0(p, lds);
    XcdBarrier xb; xb.bar = p.bar; xb.x = xb_xcc_id(); xb.st = (volatile LAS unsigned*)&xb_words;
    xcd_barrier(xb);
#pragma unroll 1
    for (int layer = 0; layer < 2; ++layer) {
        phase_inproj(p, layer, lds);
        xcd_barrier(xb);
        phase_pre(p, layer, lds);
        xcd_barrier(xb);
        phase_attn(p, layer, lds);
        xcd_barrier(xb);
        phase_norm(p);
        xcd_barrier(xb);
        phase_out(p, layer, lds);
        if (layer == 0) xcd_barrier(xb);
    }
}
#endif

extern "C" void kernel_launch(void* const* d_in, const int* in_sizes, int n_in, void* d_out, int out_size, void* d_ws, size_t ws_size, hipStream_t stream) {
    Params p{};
    p.x = (const float*)d_in[0]; p.norm_g = (const float*)d_in[1]; p.w_in = (const float*)d_in[2]; p.conv_w = (const float*)d_in[3];
    p.conv_b = (const float*)d_in[4]; p.conv_ln_g = (const float*)d_in[5]; p.conv_ln_b = (const float*)d_in[6]; p.conv_pw_w = (const float*)d_in[7];
    p.conv_pw_b = (const float*)d_in[8]; p.q_norm_g = (const float*)d_in[9]; p.w_uq = (const float*)d_in[10]; p.kv_norm_g = (const float*)d_in[11];
    p.w_ukv = (const float*)d_in[12]; p.qk_q_g = (const float*)d_in[13]; p.qk_k_g = (const float*)d_in[14]; p.sg_ln_g = (const float*)d_in[15];
    p.sg_ln_b = (const float*)d_in[16]; p.sg_w = (const float*)d_in[17]; p.sg_b = (const float*)d_in[18]; p.branch_norm_g = (const float*)d_in[19];
    p.w_out = (const float*)d_in[20];
    p.out = (float*)d_out;
    char* ws = (char*)d_ws; size_t off = 0;
    auto take = [&](size_t bytes) { char* r = ws + off; off += (bytes + 255) & ~(size_t)255; return r; };
    p.proj = (bf16_t*)take((size_t)NT * NIN * 2);
    p.xb = (bf16_t*)take((size_t)NT * 1024 * 2);
    p.Q = (bf16_t*)take((size_t)16 * SEQ * 96 * 2);
    p.K = (bf16_t*)take((size_t)16 * SEQ * 96 * 2);
    p.VT = (bf16_t*)take((size_t)16 * 64 * SEQ * 2);
    p.Y = (bf16_t*)take((size_t)NT * 1024 * 2);
    p.WinT = (bf16_t*)take((size_t)2 * 3104 * 1024 * 2);
    p.WuqT = (bf16_t*)take((size_t)2 * 768 * 768 * 2);
    p.WukvT = (bf16_t*)take((size_t)2 * 1024 * 256 * 2);
    p.PwT = (bf16_t*)take((size_t)2 * 256 * 256 * 2);
    p.WoutT = (bf16_t*)take((size_t)2 * 1024 * 1024 * 2);
    p.SgW = (bf16_t*)take((size_t)2 * 4 * 128 * 128 * 2);
    p.ss_x = (float*)take((size_t)NT * 8 * 4);
    p.ss_p = (float*)take((size_t)NT * 8 * 4);
    p.ss_m = (float*)take((size_t)NT * 8 * 4);
    p.ss_s = (float*)take((size_t)NT * 4);
    p.rope = (float*)take((size_t)SEQ * 32 * 4);
    p.bar = (unsigned*)take(16384);
    for (int i = 0; i < 16; ++i) p.invf[i] = powf(10000.0f, -(float)i / 16.0f);
    if (off > ws_size) { fprintf(stderr, "workspace too small: need %zu have %zu\n", off, ws_size); return; }
#if MK_LAUNCHES == 1
    static int grid_blocks = 0;
    if (!grid_blocks) {
        int dev = 0, cus = 0, per_cu = 0;
        hipGetDevice(&dev);
        hipDeviceGetAttribute(&cus, hipDeviceAttributeMultiprocessorCount, dev);
        hipOccupancyMaxActiveBlocksPerMultiprocessor(&per_cu, mega_kernel, 256, 0);
        if (per_cu > 2) per_cu = 2;
        grid_blocks = cus * per_cu;
    }
    void* args[] = {&p};
    hipError_t e = hipLaunchCooperativeKernel((void*)mega_kernel, dim3(grid_blocks), dim3(256), args, 0, stream);
    if (e != hipSuccess) fprintf(stderr, "cooperative launch failed: %s (grid %d)\n", hipGetErrorString(e), grid_blocks);
#endif
}
```

```cpp
#include <hip/hip_runtime.h>
#include <hip/hip_cooperative_groups.h>
#include <cstdio>
#include <cmath>
namespace cg = cooperative_groups;

#ifndef MK_LAUNCHES
#define MK_LAUNCHES 1
#endif

typedef unsigned short bf16_t;
typedef short bf16x8 __attribute__((ext_vector_type(8)));
typedef float f32x16 __attribute__((ext_vector_type(16)));
typedef float f32x4 __attribute__((ext_vector_type(4)));
typedef float f32x2 __attribute__((ext_vector_type(2)));
typedef __bf16 bf2_t __attribute__((ext_vector_type(2)));
typedef unsigned u32x4 __attribute__((ext_vector_type(4)));
typedef unsigned u32x2 __attribute__((ext_vector_type(2)));
#define DI __device__ __forceinline__

constexpr int NT = 16384, SEQ = 8192, NIN = 3104;
constexpr int C_A = 0, C_AG = 256, C_ZC = 512, C_CQ = 768, C_CKV = 1536, C_ZM = 1792, C_U = 2304, C_V = 2560, C_ZS = 2816, C_KR = 3072;
constexpr int LROW = 144;
constexpr int LDS_BYTES = 69632;
constexpr float EPS = 1e-6f;

struct Params {
    const float* x; const float* norm_g; const float* w_in; const float* conv_w; const float* conv_b;
    const float* conv_ln_g; const float* conv_ln_b; const float* conv_pw_w; const float* conv_pw_b;
    const float* q_norm_g; const float* w_uq; const float* kv_norm_g; const float* w_ukv;
    const float* qk_q_g; const float* qk_k_g; const float* sg_ln_g; const float* sg_ln_b;
    const float* sg_w; const float* sg_b; const float* branch_norm_g; const float* w_out;
    float* out;
    bf16_t* proj; bf16_t* xb; bf16_t* Q; bf16_t* K; bf16_t* VT; bf16_t* Y;
    bf16_t* WinT; bf16_t* WuqT; bf16_t* WukvT; bf16_t* PwT; bf16_t* WoutT; bf16_t* SgW;
    float* ss_x; float* ss_p; float* ss_m; float* ss_s; float* rope;
    float invf[16];
    unsigned* bar; unsigned long long pad_;
};

DI unsigned pk(float lo, float hi) { f32x2 v = {lo, hi}; return __builtin_bit_cast(unsigned, __builtin_convertvector(v, bf2_t)); }
DI float bflo(unsigned w) { return __uint_as_float(w << 16); }
DI float bfhi(unsigned w) { return __uint_as_float(w & 0xffff0000u); }
DI float fexp2(float x) { return __builtin_amdgcn_exp2f(x); }
DI float rcpf_(float x) { return __builtin_amdgcn_rcpf(x); }
DI float sigmoidf_(float x) { return rcpf_(1.0f + __expf(-x)); }
DI float siluf_(float x) { return x * rcpf_(1.0f + __expf(-x)); }
DI float geluf_(float x) { const float u = 0.7978845608028654f * (x + 0.044715f * x * x * x); return x * rcpf_(1.0f + __expf(-2.0f * u)); }
DI unsigned opaque0() { unsigned z = 0; asm volatile("" : "+v"(z)); return z; }
DI int otid() { return (int)(threadIdx.x + opaque0()); }
DI int crow(int reg, int h) { return (reg & 3) + 8 * (reg >> 2) + 4 * h; }
DI f32x16 mfma(bf16x8 a, bf16x8 b, f32x16 c) { return __builtin_amdgcn_mfma_f32_32x32x16_bf16(a, b, c, 0, 0, 0); }
DI float sum8(const float* p) { const f32x4 a = *(const f32x4*)p, b = *(const f32x4*)(p + 4); return (a.x + a.y) + (a.z + a.w) + (b.x + b.y) + (b.z + b.w); }

template <int NFB, int NTB>
DI void gemm_tile(const bf16_t* __restrict__ Wp, int ldw, const bf16_t* __restrict__ Tp, int ldt, int K, char* lds, f32x16 (&acc)[NFB][NTB]) {
    constexpr int WROWS = NFB * 32, WCH = NFB, TCH = NTB * 4;
    char* ldsW = lds; char* ldsT = lds + WROWS * LROW;
    const int tid = otid(), lane = tid & 63, wave = tid >> 6, l31 = lane & 31, hh = lane >> 5;
    const int cr = tid >> 3, ckc = tid & 7;
    u32x4 wreg[WCH], treg[TCH];
    const bf16_t* wsrc = Wp + (size_t)cr * ldw + ckc * 8;
    const bf16_t* tsrc = Tp + (size_t)cr * ldt + ckc * 8;
#pragma unroll
    for (int i = 0; i < WCH; ++i) wreg[i] = *(const u32x4*)(wsrc + (size_t)(32 * i) * ldw);
#pragma unroll
    for (int i = 0; i < TCH; ++i) treg[i] = *(const u32x4*)(tsrc + (size_t)(32 * i) * ldt);
    const int nk = K >> 6;
    char* wdst = ldsW + cr * LROW + ckc * 16;
    char* tdst = ldsT + cr * LROW + ckc * 16;
    const char* wfp = ldsW + l31 * LROW + hh * 16;
    const char* tfp = ldsT + (wave * NTB * 32 + l31) * LROW + hh * 16;
    for (int kt = 0; kt < nk; ++kt) {
        __syncthreads();
#pragma unroll
        for (int i = 0; i < WCH; ++i) *(u32x4*)(wdst + 32 * i * LROW) = wreg[i];
#pragma unroll
        for (int i = 0; i < TCH; ++i) *(u32x4*)(tdst + 32 * i * LROW) = treg[i];
        __syncthreads();
        if (kt + 1 < nk) {
            const int ko = (kt + 1) * 64;
#pragma unroll
            for (int i = 0; i < WCH; ++i) wreg[i] = *(const u32x4*)(wsrc + (size_t)(32 * i) * ldw + ko);
#pragma unroll
            for (int i = 0; i < TCH; ++i) treg[i] = *(const u32x4*)(tsrc + (size_t)(32 * i) * ldt + ko);
        }
#pragma unroll
        for (int s = 0; s < 4; ++s) {
            bf16x8 wf[NFB], tf[NTB];
#pragma unroll
            for (int fb = 0; fb < NFB; ++fb) wf[fb] = *(const bf16x8*)(wfp + fb * 32 * LROW + s * 32);
#pragma unroll
            for (int tb = 0; tb < NTB; ++tb) tf[tb] = *(const bf16x8*)(tfp + tb * 32 * LROW + s * 32);
#pragma unroll
            for (int fb = 0; fb < NFB; ++fb)
#pragma unroll
                for (int tb = 0; tb < NTB; ++tb) acc[fb][tb] = mfma(wf[fb], tf[tb], acc[fb][tb]);
        }
    }
}

template <int NFB, int NTB>
DI void gemm_issue(const bf16_t* __restrict__ Wp, int ldw, const bf16_t* __restrict__ Tp, int ldt, u32x4 (&wreg)[NFB], u32x4 (&treg)[NTB * 4]) {
    const int tid = otid(), cr = tid >> 3, ckc = tid & 7;
    const bf16_t* wsrc = Wp + (size_t)cr * ldw + ckc * 8;
    const bf16_t* tsrc = Tp + (size_t)cr * ldt + ckc * 8;
#pragma unroll
    for (int i = 0; i < NFB; ++i) wreg[i] = *(const u32x4*)(wsrc + (size_t)(32 * i) * ldw);
#pragma unroll
    for (int i = 0; i < NTB * 4; ++i) treg[i] = *(const u32x4*)(tsrc + (size_t)(32 * i) * ldt);
}
template <int NFB, int NTB>
DI void gemm_run(const bf16_t* __restrict__ Wp, int ldw, const bf16_t* __restrict__ Tp, int ldt, int K, char* lds, f32x16 (&acc)[NFB][NTB],
                 u32x4 (&wreg)[NFB], u32x4 (&treg)[NTB * 4]) {
    constexpr int WROWS = NFB * 32, WCH = NFB, TCH = NTB * 4;
    char* ldsW = lds; char* ldsT = lds + WROWS * LROW;
    const int tid = otid(), lane = tid & 63, wave = tid >> 6, l31 = lane & 31, hh = lane >> 5;
    const int cr = tid >> 3, ckc = tid & 7;
    const bf16_t* wsrc = Wp + (size_t)cr * ldw + ckc * 8;
    const bf16_t* tsrc = Tp + (size_t)cr * ldt + ckc * 8;
    const int nk = K >> 6;
    char* wdst = ldsW + cr * LROW + ckc * 16;
    char* tdst = ldsT + cr * LROW + ckc * 16;
    const char* wfp = ldsW + l31 * LROW + hh * 16;
    const char* tfp = ldsT + (wave * NTB * 32 + l31) * LROW + hh * 16;
    for (int kt = 0; kt < nk; ++kt) {
        __syncthreads();
#pragma unroll
        for (int i = 0; i < WCH; ++i) *(u32x4*)(wdst + 32 * i * LROW) = wreg[i];
#pragma unroll
        for (int i = 0; i < TCH; ++i) *(u32x4*)(tdst + 32 * i * LROW) = treg[i];
        __syncthreads();
        if (kt + 1 < nk) {
            const int ko = (kt + 1) * 64;
#pragma unroll
            for (int i = 0; i < WCH; ++i) wreg[i] = *(const u32x4*)(wsrc + (size_t)(32 * i) * ldw + ko);
#pragma unroll
            for (int i = 0; i < TCH; ++i) treg[i] = *(const u32x4*)(tsrc + (size_t)(32 * i) * ldt + ko);
        }
#pragma unroll
        for (int s = 0; s < 4; ++s) {
            bf16x8 wf[NFB], tf[NTB];
#pragma unroll
            for (int fb = 0; fb < NFB; ++fb) wf[fb] = *(const bf16x8*)(wfp + fb * 32 * LROW + s * 32);
#pragma unroll
            for (int tb = 0; tb < NTB; ++tb) tf[tb] = *(const bf16x8*)(tfp + tb * 32 * LROW + s * 32);
#pragma unroll
            for (int fb = 0; fb < NFB; ++fb)
#pragma unroll
                for (int tb = 0; tb < NTB; ++tb) acc[fb][tb] = mfma(wf[fb], tf[tb], acc[fb][tb]);
        }
    }
}

template <int NFB, int NTB> DI void zero_acc(f32x16 (&acc)[NFB][NTB]) {
#pragma unroll
    for (int a = 0; a < NFB; ++a)
#pragma unroll
        for (int b = 0; b < NTB; ++b)
#pragma unroll
            for (int r = 0; r < 16; ++r) acc[a][b][r] = 0.f;
}

DI void tconv_tile(const float* __restrict__ src, int ldsrc, int ks, int ns, int nvalid, const float* __restrict__ scale,
                   bf16_t* __restrict__ dst, int lddst, int kd, int nd, float* tile) {
    const int tid = threadIdx.x;
    __syncthreads();
    {
        const int n = tid & 63, kk = tid >> 6;
        float v[16];
#pragma unroll
        for (int r = 0; r < 16; ++r) v[r] = (n < nvalid) ? src[(size_t)(ks + r * 4 + kk) * ldsrc + ns + n] : 0.f;
        if (scale) {
#pragma unroll
            for (int r = 0; r < 16; ++r) v[r] *= scale[ks + r * 4 + kk];
        }
#pragma unroll
        for (int r = 0; r < 16; ++r) tile[(r * 4 + kk) * 65 + n] = v[r];
    }
    __syncthreads();
    {
        const int n = tid >> 2, kq = tid & 3;
        if (n < nvalid) {
            const float* tp = tile + (kq * 16) * 65 + n;
            u32x4 a, b;
            a.x = pk(tp[0 * 65], tp[1 * 65]);  a.y = pk(tp[2 * 65], tp[3 * 65]);   a.z = pk(tp[4 * 65], tp[5 * 65]);   a.w = pk(tp[6 * 65], tp[7 * 65]);
            b.x = pk(tp[8 * 65], tp[9 * 65]);  b.y = pk(tp[10 * 65], tp[11 * 65]); b.z = pk(tp[12 * 65], tp[13 * 65]); b.w = pk(tp[14 * 65], tp[15 * 65]);
            bf16_t* d = dst + (size_t)(nd + n) * lddst + kd + kq * 16;
            *(u32x4*)d = a; *(u32x4*)(d + 8) = b;
        }
    }
}

DI void phase0(const Params& p, char* lds) {
    float* tile = (float*)lds;
    const int tid = threadIdx.x, lane = tid & 63, wave = tid >> 6;
    for (int item = blockIdx.x; item < 2 * 1264; item += gridDim.x) {
        const int layer = item / 1264; int id = item % 1264;
        if (id < 784) {
            const int kt = id & 15, nt = id >> 4, nd = nt * 64;
            int ns, nv = 64;
            if (nd < 1792) ns = nd; else if (nd < 3072) ns = nd + 32; else { ns = 1792; nv = 32; }
            tconv_tile(p.w_in + (size_t)layer * 1024 * 3104, 3104, kt * 64, ns, nv, p.norm_g + layer * 1024,
                       p.WinT + (size_t)layer * 3104 * 1024, 1024, kt * 64, nd, tile);
        } else if ((id -= 784) < 144) {
            const int kt = id % 12, nt = id / 12;
            tconv_tile(p.w_uq + (size_t)layer * 768 * 768, 768, kt * 64, nt * 64, 64, p.q_norm_g + layer * 768,
                       p.WuqT + (size_t)layer * 768 * 768, 768, kt * 64, nt * 64, tile);
        } else if ((id -= 144) < 64) {
            const int kt = id & 3, nt = id >> 2;
            tconv_tile(p.w_ukv + (size_t)layer * 256 * 1024, 1024, kt * 64, nt * 64, 64, p.kv_norm_g + layer * 256,
                       p.WukvT + (size_t)layer * 1024 * 256, 256, kt * 64, nt * 64, tile);
        } else if ((id -= 64) < 16) {
            const int kt = id & 3, nt = id >> 2;
            tconv_tile(p.conv_pw_w + (size_t)layer * 256 * 256, 256, kt * 64, nt * 64, 64, nullptr,
                       p.PwT + (size_t)layer * 256 * 256, 256, kt * 64, nt * 64, tile);
        } else {
            id -= 16;
            const int kt = id & 15, nt = id >> 4, kd = kt * 64;
            const int ks = kd < 768 ? kd + 256 : kd - 768;
            tconv_tile(p.w_out + (size_t)layer * 1024 * 1024, 1024, ks, nt * 64, 64, p.branch_norm_g + layer * 1024,
                       p.WoutT + (size_t)layer * 1024 * 1024, 1024, kd, nt * 64, tile);
        }
    }
    const int gtid = blockIdx.x * 256 + tid, nthr = gridDim.x * 256;
    for (int e = gtid; e < 2 * 4 * 128 * 128; e += nthr) {
        const int t = (e >> 7) & 127, s = e & 127;
        p.SgW[e] = (bf16_t)(s <= t ? (pk(p.sg_w[e], 0.f) & 0xffffu) : 0u);
    }
    for (int e = gtid; e < SEQ * 16; e += nthr) {
        const int pos = e >> 4, i = e & 15;
        const float ang = (float)pos * p.invf[i];
        const double rev = (double)ang * 0.15915494309189535;
        const float fr = (float)(rev - floor(rev));
        p.rope[pos * 32 + i] = __builtin_amdgcn_cosf(fr);
        p.rope[pos * 32 + 16 + i] = __builtin_amdgcn_sinf(fr);
    }
    for (int row = (blockIdx.x * 4 + wave) * 2; row < NT; row += gridDim.x * 8) {
        f32x4 v[2][4];
#pragma unroll
        for (int rr = 0; rr < 2; ++rr)
#pragma unroll
            for (int i = 0; i < 4; ++i) v[rr][i] = ((const f32x4*)(p.x + (size_t)(row + rr) * 1024))[lane + 64 * i];
#pragma unroll
        for (int rr = 0; rr < 2; ++rr)
#pragma unroll
            for (int i = 0; i < 4; ++i) {
                const f32x4 a = v[rr][i];
                float ss = a.x * a.x + a.y * a.y + a.z * a.z + a.w * a.w;
                u32x2 w; w.x = pk(a.x, a.y); w.y = pk(a.z, a.w);
                *(u32x2*)(p.xb + (size_t)(row + rr) * 1024 + 4 * (lane + 64 * i)) = w;
                ss += __shfl_xor(ss, 16); ss += __shfl_xor(ss, 8); ss += __shfl_xor(ss, 4); ss += __shfl_xor(ss, 2); ss += __shfl_xor(ss, 1);
                if ((lane & 31) == 0) p.ss_x[(row + rr) * 8 + 2 * i + (lane >> 5)] = ss;
            }
    }
}

template <int NFB>
DI void epi_inproj(const Params& p, f32x16 (&acc)[NFB][2], int tok0, int col0, int ssslot, char* lds) {
    __builtin_amdgcn_sched_barrier(0);
    const int lane = otid() & 63, wave = otid() >> 6, l31 = lane & 31, hh = lane >> 5;
    constexpr int RB = NFB * 64 + 16;
    constexpr int CH = NFB * 4;
    constexpr int RPP = 64 / CH;
    char* wl = lds + wave * (32 * RB);
    __syncthreads();
#pragma unroll
    for (int tb = 0; tb < 2; ++tb) {
        const int tw = tok0 + wave * 64 + tb * 32;
        const int t = tw + l31;
        const float r = rsqrtf(sum8(p.ss_x + t * 8) * (1.0f / 1024.0f) + EPS);
        float ss = 0.f;
#pragma unroll
        for (int fb = 0; fb < NFB; ++fb)
#pragma unroll
            for (int g = 0; g < 4; ++g) {
                const float v0 = acc[fb][tb][4 * g] * r, v1 = acc[fb][tb][4 * g + 1] * r, v2 = acc[fb][tb][4 * g + 2] * r, v3 = acc[fb][tb][4 * g + 3] * r;
                ss += v0 * v0 + v1 * v1 + v2 * v2 + v3 * v3;
                u32x2 w; w.x = pk(v0, v1); w.y = pk(v2, v3);
                *(u32x2*)(wl + l31 * RB + (32 * fb + 8 * g + 4 * hh) * 2) = w;
            }
        if (ssslot >= 0) { ss += __shfl_xor(ss, 32); if (hh == 0) p.ss_p[t * 8 + ssslot] = ss; }
        const int rr = lane / CH, cc = lane % CH;
#pragma unroll
        for (int i = 0; i < 32 / RPP; ++i) {
            const int row = rr + RPP * i;
            const u32x4 w = *(const u32x4*)(wl + row * RB + cc * 16);
            *(u32x4*)(p.proj + (size_t)(tw + row) * NIN + col0 + 8 * cc) = w;
        }
    }
}

DI void phase_inproj(const Params& p, int layer, char* lds) {
    const bf16_t* W = p.WinT + (size_t)layer * 3104 * 1024;
    u32x4 wreg[4], treg[8];
    int item = blockIdx.x;
    int tt = 0, ft = 0;
    if (item < 1536) {
        const int r = item >> 9, b = item & 511, x = b & 7, j = b >> 3;
        tt = 8 * x + (j >> 3); ft = 8 * r + (j & 7);
        gemm_issue<4, 2>(W + (size_t)ft * 128 * 1024, 1024, p.xb + (size_t)tt * 256 * 1024, 1024, wreg, treg);
    }
    while (item < 1536) {
        f32x16 acc[4][2]; zero_acc(acc);
        gemm_run<4, 2>(W + (size_t)ft * 128 * 1024, 1024, p.xb + (size_t)tt * 256 * 1024, 1024, 1024, lds, acc, wreg, treg);
        const int ctt = tt, cft = ft;
        item += gridDim.x;
        if (item < 1536) {
            const int r = item >> 9, b = item & 511, x = b & 7, j = b >> 3;
            tt = 8 * x + (j >> 3); ft = 8 * r + (j & 7);
            gemm_issue<4, 2>(W + (size_t)ft * 128 * 1024, 1024, p.xb + (size_t)tt * 256 * 1024, 1024, wreg, treg);
        }
        const int slot = (cft >= 6 && cft < 14) ? cft - 6 : -1;
        epi_inproj<4>(p, acc, ctt * 256, cft * 128, slot, lds);
    }
    for (int mi = blockIdx.x; mi < 64; mi += gridDim.x) {
        f32x16 acc[1][2]; zero_acc(acc);
        gemm_tile<1, 2>(W + (size_t)3072 * 1024, 1024, p.xb + (size_t)mi * 256 * 1024, 1024, 1024, lds, acc);
        epi_inproj<1>(p, acc, mi * 256, C_KR, -1, lds);
    }
}

DI void epi_q(const Params& p, int layer, f32x16 (&acc)[3][2], int tok0, int head) {
    __builtin_amdgcn_sched_barrier(0);
    const int lane = otid() & 63, wave = otid() >> 6, l31 = lane & 31, hh = lane >> 5;
    const float* g = p.qk_q_g + layer * 96;
    const float QS = 0.10206207261596577f * 1.4426950408889634f;
#pragma unroll
    for (int tb = 0; tb < 2; ++tb) {
        const int t = tok0 + wave * 64 + tb * 32 + l31, pos = t & (SEQ - 1), bidx = t >> 13;
        const float* sp = p.ss_p + t * 8;
        const float rc = rsqrtf(((sp[0] + sp[1]) + (sp[2] + sp[3]) + (sp[4] + sp[5])) * (1.0f / 768.0f) + EPS);
        float ss = 0.f;
#pragma unroll
        for (int fb = 0; fb < 3; ++fb)
#pragma unroll
            for (int r = 0; r < 16; ++r) ss += acc[fb][tb][r] * acc[fb][tb][r];
        ss += __shfl_xor(ss, 32);
        const float rn = rc * rsqrtf(ss * rc * rc * (1.0f / 96.0f) + EPS);
        bf16_t* dst = p.Q + ((size_t)(bidx * 8 + head) * SEQ + pos) * 96 + 4 * hh;
#pragma unroll
        for (int fb = 0; fb < 2; ++fb)
#pragma unroll
            for (int gq = 0; gq < 4; ++gq) {
                const f32x4 gv = *(const f32x4*)(g + 32 * fb + 8 * gq + 4 * hh);
                const float s = rn * QS;
                u32x2 w; w.x = pk(acc[fb][tb][4 * gq] * s * gv.x, acc[fb][tb][4 * gq + 1] * s * gv.y);
                w.y = pk(acc[fb][tb][4 * gq + 2] * s * gv.z, acc[fb][tb][4 * gq + 3] * s * gv.w);
                *(u32x2*)(dst + 32 * fb + 8 * gq) = w;
            }
        const float* rp = p.rope + pos * 32;
#pragma unroll
        for (int gq = 0; gq < 2; ++gq) {
            const int i0 = 8 * gq + 4 * hh;
            const f32x4 c4 = *(const f32x4*)(rp + i0), s4 = *(const f32x4*)(rp + 16 + i0);
            const f32x4 g1 = *(const f32x4*)(g + 64 + i0), g2 = *(const f32x4*)(g + 80 + i0);
            float o1[4], o2[4];
#pragma unroll
            for (int i = 0; i < 4; ++i) {
                const float x1 = acc[2][tb][4 * gq + i] * rn * g1[i] * QS, x2 = acc[2][tb][4 * gq + i + 8] * rn * g2[i] * QS;
                o1[i] = x1 * c4[i] - x2 * s4[i]; o2[i] = x1 * s4[i] + x2 * c4[i];
            }
            u32x2 w1, w2; w1.x = pk(o1[0], o1[1]); w1.y = pk(o1[2], o1[3]); w2.x = pk(o2[0], o2[1]); w2.y = pk(o2[2], o2[3]);
            *(u32x2*)(dst + 64 + 8 * gq) = w1;
            *(u32x2*)(dst + 80 + 8 * gq) = w2;
        }
    }
}

DI void epi_kv(const Params& p, int layer, f32x16 (&acc)[4][2], int tok0, int head) {
    __builtin_amdgcn_sched_barrier(0);
    const int lane = otid() & 63, wave = otid() >> 6, l31 = lane & 31, hh = lane >> 5;
    const float* g = p.qk_k_g + layer * 96;
#pragma unroll
    for (int tb = 0; tb < 2; ++tb) {
        const int t = tok0 + wave * 64 + tb * 32 + l31, pos = t & (SEQ - 1), bidx = t >> 13;
        const float rc = rsqrtf((p.ss_p[t * 8 + 6] + p.ss_p[t * 8 + 7]) * (1.0f / 256.0f) + EPS);
        const int pp = (pos & ~15) | ((pos & 4) << 1) | ((pos & 8) >> 1) | (pos & 3);
        char* vbase = (char*)(p.VT + (size_t)((tok0 >> 13) * 8 + head) * 64 * SEQ);
        const unsigned voff = (unsigned)(4 * hh * SEQ + pp) * 2u;
#pragma unroll
        for (int fb = 2; fb < 4; ++fb)
#pragma unroll
            for (int r = 0; r < 16; ++r) {
                const int dvc = 32 * (fb - 2) + (r & 3) + 8 * (r >> 2);
                *(bf16_t*)(vbase + (size_t)dvc * SEQ * 2 + voff) = (bf16_t)(pk(acc[fb][tb][r] * rc, 0.f) & 0xffffu);
            }
        asm volatile("" ::: "memory");
        const bf16_t* kr = p.proj + (size_t)t * NIN + C_KR + 8 * hh;
        const u32x4 ka = *(const u32x4*)kr, kb = *(const u32x4*)(kr + 16);
        float x1[8], x2[8];
#pragma unroll
        for (int i = 0; i < 4; ++i) { x1[2 * i] = bflo(ka[i]); x1[2 * i + 1] = bfhi(ka[i]); x2[2 * i] = bflo(kb[i]); x2[2 * i + 1] = bfhi(kb[i]); }
        float ss = 0.f, sr = 0.f;
#pragma unroll
        for (int i = 0; i < 8; ++i) sr += x1[i] * x1[i] + x2[i] * x2[i];
#pragma unroll
        for (int fb = 0; fb < 2; ++fb)
#pragma unroll
            for (int r = 0; r < 16; ++r) ss += acc[fb][tb][r] * acc[fb][tb][r];
        ss = ss * rc * rc + sr;
        ss += __shfl_xor(ss, 32);
        const float rn = rsqrtf(ss * (1.0f / 96.0f) + EPS);
        const float rk = rn * rc;
        bf16_t* kd = p.K + ((size_t)(bidx * 8 + head) * SEQ + pos) * 96;
#pragma unroll
        for (int fb = 0; fb < 2; ++fb)
#pragma unroll
            for (int gq = 0; gq < 4; ++gq) {
                const int f = 32 * fb + 8 * gq + 4 * hh;
                const f32x4 gv = *(const f32x4*)(g + f);
                u32x2 w; w.x = pk(acc[fb][tb][4 * gq] * rk * gv.x, acc[fb][tb][4 * gq + 1] * rk * gv.y);
                w.y = pk(acc[fb][tb][4 * gq + 2] * rk * gv.z, acc[fb][tb][4 * gq + 3] * rk * gv.w);
                *(u32x2*)(kd + f) = w;
            }
        {
            const float* rp = p.rope + pos * 32 + 8 * hh;
            float o1[8], o2[8];
#pragma unroll
            for (int q4 = 0; q4 < 2; ++q4) {
                const f32x4 c4 = *(const f32x4*)(rp + 4 * q4), s4 = *(const f32x4*)(rp + 16 + 4 * q4);
                const f32x4 g1 = *(const f32x4*)(g + 64 + 8 * hh + 4 * q4), g2 = *(const f32x4*)(g + 80 + 8 * hh + 4 * q4);
#pragma unroll
                for (int i = 0; i < 4; ++i) {
                    const float a = x1[4 * q4 + i] * rn * g1[i], b = x2[4 * q4 + i] * rn * g2[i];
                    o1[4 * q4 + i] = a * c4[i] - b * s4[i]; o2[4 * q4 + i] = a * s4[i] + b * c4[i];
                }
            }
            u32x4 w1, w2;
            w1.x = pk(o1[0], o1[1]); w1.y = pk(o1[2], o1[3]); w1.z = pk(o1[4], o1[5]); w1.w = pk(o1[6], o1[7]);
            w2.x = pk(o2[0], o2[1]); w2.y = pk(o2[2], o2[3]); w2.z = pk(o2[4], o2[5]); w2.w = pk(o2[6], o2[7]);
            *(u32x4*)(kd + 64 + 8 * hh) = w1;
            *(u32x4*)(kd + 80 + 8 * hh) = w2;
        }
    }
}

DI void conv_item(const Params& p, int layer, int ct, char* lds) {
    const int tid = otid(), lane = tid & 63, wave = tid >> 6, l31 = lane & 31, hh = lane >> 5;
    constexpr int CR = 528;
    const int t0 = ct * 64, pos0 = t0 & (SEQ - 1);
    __syncthreads();
#pragma unroll 1
    for (int c0 = tid; c0 < 94 * 32; c0 += 1024) {
        u32x4 a[4], g[4];
#pragma unroll
        for (int u = 0; u < 4; ++u) {
            const int c = c0 + 256 * u, i = c >> 5, ch = c & 31;
            a[u] = (u32x4){0u, 0u, 0u, 0u}; g[u] = a[u];
            if (c < 94 * 32 && pos0 - 30 + i >= 0) {
                const bf16_t* src = p.proj + (size_t)(t0 - 30 + i) * NIN + 8 * ch;
                a[u] = *(const u32x4*)(src + C_A); g[u] = *(const u32x4*)(src + C_AG);
            }
        }
#pragma unroll
        for (int u = 0; u < 4; ++u) {
            const int c = c0 + 256 * u, i = c >> 5, ch = c & 31;
            if (c < 94 * 32) {
                u32x4 w;
#pragma unroll
                for (int e = 0; e < 4; ++e) w[e] = pk(bflo(a[u][e]) * sigmoidf_(bflo(g[u][e])), bfhi(a[u][e]) * sigmoidf_(bfhi(g[u][e])));
                *(u32x4*)(lds + i * CR + ch * 16) = w;
            }
        }
    }
    __syncthreads();
    {
        float w[31];
        const char* cw = (const char*)(p.conv_w + (size_t)layer * 31 * 256);
        const unsigned cwo = (unsigned)tid * 4u;
#pragma unroll
        for (int k = 0; k < 31; ++k) w[k] = *(const float*)(cw + k * 1024 + cwo);
        const float cb = p.conv_b[layer * 256 + tid];
#pragma unroll 1
        for (int tg = 0; tg < 8; ++tg) {
            float in[38];
            const char* base = lds + (8 * tg) * CR + 2 * tid;
#pragma unroll
            for (int i = 0; i < 38; ++i) in[i] = __uint_as_float((unsigned)(*(const bf16_t*)(base + i * CR)) << 16);
#pragma unroll
            for (int j = 0; j < 8; ++j) {
                float o = cb;
#pragma unroll
                for (int k = 0; k < 31; ++k) o += w[k] * in[j + k];
                *(bf16_t*)(lds + (8 * tg + j) * CR + 2 * tid) = (bf16_t)(pk(o, 0.f) & 0xffffu);
            }
        }
    }
    __syncthreads();
    {
        const int tok = tid >> 2, part = tid & 3;
        char* base = lds + tok * CR + part * 128;
        float v[64];
#pragma unroll
        for (int i = 0; i < 8; ++i) {
            const u32x4 w = *(const u32x4*)(base + 16 * i);
#pragma unroll
            for (int e = 0; e < 4; ++e) { v[8 * i + 2 * e] = bflo(w[e]); v[8 * i + 2 * e + 1] = bfhi(w[e]); }
        }
        float s = 0.f;
#pragma unroll
        for (int i = 0; i < 64; ++i) s += v[i];
        s += __shfl_xor(s, 1); s += __shfl_xor(s, 2);
        const float mu = s * (1.0f / 256.0f);
        float q = 0.f;
#pragma unroll
        for (int i = 0; i < 64; ++i) { const float d = v[i] - mu; q += d * d; }
        q += __shfl_xor(q, 1); q += __shfl_xor(q, 2);
        const float rs = rsqrtf(q * (1.0f / 256.0f) + EPS);
        const float* lg = p.conv_ln_g + layer * 256 + part * 64;
        const float* lb = p.conv_ln_b + layer * 256 + part * 64;
#pragma unroll
        for (int i = 0; i < 8; ++i) {
            const f32x4 g0 = *(const f32x4*)(lg + 8 * i), g1 = *(const f32x4*)(lg + 8 * i + 4);
            const f32x4 b0 = *(const f32x4*)(lb + 8 * i), b1 = *(const f32x4*)(lb + 8 * i + 4);
            float y[8];
#pragma unroll
            for (int e = 0; e < 4; ++e) { y[e] = siluf_((v[8 * i + e] - mu) * rs * g0[e] + b0[e]); y[4 + e] = siluf_((v[8 * i + 4 + e] - mu) * rs * g1[e] + b1[e]); }
            u32x4 w; w.x = pk(y[0], y[1]); w.y = pk(y[2], y[3]); w.z = pk(y[4], y[5]); w.w = pk(y[6], y[7]);
            *(u32x4*)(base + 16 * i) = w;
        }
    }
    __syncthreads();
    f32x16 acc[2][2]; zero_acc(acc);
    {
        const bf16_t* wsrc = p.PwT + (size_t)layer * 256 * 256 + (size_t)(64 * wave + l31) * 256 + 8 * hh;
        const char* tfp = lds + l31 * CR + hh * 16;
#pragma unroll 8
        for (int s = 0; s < 16; ++s) {
            bf16x8 wf[2], tf[2];
#pragma unroll
            for (int fb = 0; fb < 2; ++fb) wf[fb] = *(const bf16x8*)(wsrc + fb * 32 * 256 + 16 * s);
#pragma unroll
            for (int tb = 0; tb < 2; ++tb) tf[tb] = *(const bf16x8*)(tfp + tb * 32 * CR + s * 32);
#pragma unroll
            for (int fb = 0; fb < 2; ++fb)
#pragma unroll
                for (int tb = 0; tb < 2; ++tb) acc[fb][tb] = mfma(wf[fb], tf[tb], acc[fb][tb]);
        }
    }
    float* red = (float*)(lds + 49664);
    float ss[2] = {0.f, 0.f};
#pragma unroll
    for (int tb = 0; tb < 2; ++tb) {
        const int t = t0 + 32 * tb + l31;
#pragma unroll
        for (int fb = 0; fb < 2; ++fb)
#pragma unroll
            for (int gq = 0; gq < 4; ++gq) {
                const int f = 64 * wave + 32 * fb + 8 * gq + 4 * hh;
                const f32x4 bv = *(const f32x4*)(p.conv_pw_b + layer * 256 + f);
                const u32x2 z = *(const u32x2*)(p.proj + (size_t)t * NIN + C_ZC + f);
                const float v0 = (acc[fb][tb][4 * gq] + bv.x) * siluf_(bflo(z.x)), v1 = (acc[fb][tb][4 * gq + 1] + bv.y) * siluf_(bfhi(z.x));
                const float v2 = (acc[fb][tb][4 * gq + 2] + bv.z) * siluf_(bflo(z.y)), v3 = (acc[fb][tb][4 * gq + 3] + bv.w) * siluf_(bfhi(z.y));
                acc[fb][tb][4 * gq] = v0; acc[fb][tb][4 * gq + 1] = v1; acc[fb][tb][4 * gq + 2] = v2; acc[fb][tb][4 * gq + 3] = v3;
                ss[tb] += v0 * v0 + v1 * v1 + v2 * v2 + v3 * v3;
            }
        ss[tb] += __shfl_xor(ss[tb], 32);
        if (hh == 0) red[wave * 64 + 32 * tb + l31] = ss[tb];
    }
    __syncthreads();
#pragma unroll
    for (int tb = 0; tb < 2; ++tb) {
        const int t = t0 + 32 * tb + l31, ti = 32 * tb + l31;
        const float tot = (red[ti] + red[64 + ti]) + (red[128 + ti] + red[192 + ti]);
        const float rn = rsqrtf(tot * (1.0f / 256.0f) + EPS);
#pragma unroll
        for (int fb = 0; fb < 2; ++fb)
#pragma unroll
            for (int gq = 0; gq < 4; ++gq) {
                const int f = 64 * wave + 32 * fb + 8 * gq + 4 * hh;
                u32x2 w; w.x = pk(acc[fb][tb][4 * gq] * rn, acc[fb][tb][4 * gq + 1] * rn); w.y = pk(acc[fb][tb][4 * gq + 2] * rn, acc[fb][tb][4 * gq + 3] * rn);
                *(u32x2*)(p.Y + (size_t)t * 1024 + 768 + f) = w;
            }
    }
}

DI void sgu_item(const Params& p, int layer, int ch, char* lds) {
    const int tid = otid(), lane = tid & 63, wave = tid >> 6, l31 = lane & 31, hh = lane >> 5;
    constexpr int VR = 272;
    const int t0 = ch * 128;
    __syncthreads();
#pragma unroll 1
    for (int hf = 0; hf < 2; ++hf) {
        const int tok = 64 * hf + (tid >> 2), part = tid & 3;
        const bf16_t* src = p.proj + (size_t)(t0 + tok) * NIN + C_V;
        float v[64];
#pragma unroll
        for (int i = 0; i < 8; ++i) {
            const u32x4 w = *(const u32x4*)(src + 8 * (4 * i + part));
#pragma unroll
            for (int e = 0; e < 4; ++e) { v[8 * i + 2 * e] = geluf_(bflo(w[e])); v[8 * i + 2 * e + 1] = geluf_(bfhi(w[e])); }
        }
        float s = 0.f;
#pragma unroll
        for (int i = 0; i < 64; ++i) s += v[i];
        s += __shfl_xor(s, 1); s += __shfl_xor(s, 2);
        const float mu = s * (1.0f / 256.0f);
        float q = 0.f;
#pragma unroll
        for (int i = 0; i < 64; ++i) { const float d = v[i] - mu; q += d * d; }
        q += __shfl_xor(q, 1); q += __shfl_xor(q, 2);
        const float rs = rsqrtf(q * (1.0f / 256.0f) + EPS);
#pragma unroll
        for (int i = 0; i < 8; ++i) {
            const int c0 = 8 * (4 * i + part);
            const float* lg = p.sg_ln_g + layer * 256 + c0;
            const float* lb = p.sg_ln_b + layer * 256 + c0;
            const f32x4 g0 = *(const f32x4*)lg, g1 = *(const f32x4*)(lg + 4), b0 = *(const f32x4*)lb, b1 = *(const f32x4*)(lb + 4);
#pragma unroll
            for (int e = 0; e < 4; ++e) {
                const float y0 = (v[8 * i + e] - mu) * rs * g0[e] + b0[e], y1 = (v[8 * i + 4 + e] - mu) * rs * g1[e] + b1[e];
                *(bf16_t*)(lds + (c0 + e) * VR + tok * 2) = (bf16_t)(pk(y0, 0.f) & 0xffffu);
                *(bf16_t*)(lds + (c0 + 4 + e) * VR + tok * 2) = (bf16_t)(pk(y1, 0.f) & 0xffffu);
            }
        }
    }
    __syncthreads();
    const int tch = 32 * wave + l31, t = t0 + tch;
    float ss = 0.f;
#pragma unroll 1
    for (int hp = 0; hp < 2; ++hp) {
        f32x16 acc[4][1]; zero_acc(acc);
        const bf16_t* wsrc = p.SgW + ((size_t)(layer * 4 + 2 * hp) * 128 + 32 * wave + l31) * 128 + 8 * hh;
        const char* afp = lds + (128 * hp + l31) * VR + hh * 16;
        const int nsteps = 2 * (wave + 1);
        bf16x8 bfr[2][8];
#pragma unroll
        for (int s = 0; s < 8; ++s)
#pragma unroll
            for (int g = 0; g < 2; ++g) bfr[g][s] = (s < nsteps) ? *(const bf16x8*)(wsrc + (size_t)g * 128 * 128 + 16 * s) : (bf16x8){0, 0, 0, 0, 0, 0, 0, 0};
#pragma unroll
        for (int s = 0; s < 8; ++s) {
            if (s < nsteps) {
#pragma unroll
                for (int g = 0; g < 2; ++g)
#pragma unroll
                    for (int e = 0; e < 2; ++e) {
                        const int fb = 2 * g + e;
                        const bf16x8 afr = *(const bf16x8*)(afp + fb * 32 * VR + s * 32);
                        acc[fb][0] = mfma(afr, bfr[g][s], acc[fb][0]);
                    }
            }
        }
#pragma unroll
        for (int fb = 0; fb < 4; ++fb) {
            const float bias = p.sg_b[(layer * 4 + 2 * hp + (fb >> 1)) * 128 + tch];
#pragma unroll
            for (int gq = 0; gq < 4; ++gq) {
                const int f = 128 * hp + 32 * fb + 8 * gq + 4 * hh;
                const u32x2 u = *(const u32x2*)(p.proj + (size_t)t * NIN + C_U + f);
                const u32x2 z = *(const u32x2*)(p.proj + (size_t)t * NIN + C_ZS + f);
                const float v0 = geluf_(bflo(u.x)) * (acc[fb][0][4 * gq] + bias) * siluf_(bflo(z.x));
                const float v1 = geluf_(bfhi(u.x)) * (acc[fb][0][4 * gq + 1] + bias) * siluf_(bfhi(z.x));
                const float v2 = geluf_(bflo(u.y)) * (acc[fb][0][4 * gq + 2] + bias) * siluf_(bflo(z.y));
                const float v3 = geluf_(bfhi(u.y)) * (acc[fb][0][4 * gq + 3] + bias) * siluf_(bfhi(z.y));
                ss += v0 * v0 + v1 * v1 + v2 * v2 + v3 * v3;
                u32x2 w; w.x = pk(v0, v1); w.y = pk(v2, v3);
                *(u32x2*)(p.Y + (size_t)t * 1024 + 512 + f) = w;
            }
        }
    }
    (void)ss;
}

DI void phase_pre(const Params& p, int layer, char* lds) {
    for (int item = blockIdx.x; item < 512; item += gridDim.x) {
        const int x = item & 7, j = item >> 3, tt = 8 * x + (j >> 3), head = j & 7;
        f32x16 acc[3][2]; zero_acc(acc);
        gemm_tile<3, 2>(p.WuqT + (size_t)layer * 768 * 768 + (size_t)head * 96 * 768, 768, p.proj + (size_t)tt * 256 * NIN + C_CQ, NIN, 768, lds, acc);
        epi_q(p, layer, acc, tt * 256, head);
    }
    for (int item = blockIdx.x; item < 512; item += gridDim.x) {
        const int x = item & 7, j = item >> 3, tt = 8 * x + (j >> 3), head = j & 7;
        f32x16 acc[4][2]; zero_acc(acc);
        gemm_tile<4, 2>(p.WukvT + (size_t)layer * 1024 * 256 + (size_t)head * 128 * 256, 256, p.proj + (size_t)tt * 256 * NIN + C_CKV, NIN, 256, lds, acc);
        epi_kv(p, layer, acc, tt * 256, head);
    }
}

template <bool FIXED>
DI void attn_qtile(const Params& p, int bh, int qt, char* lds) {
    const int tid = otid(), lane = tid & 63, wave = tid >> 6, l31 = lane & 31, hh = lane >> 5;
    constexpr int KR = 208, KB = 64 * KR, VB = 64 * LROW, VOFF = 2 * KB;
    const int q0w = qt * 128 + 32 * wave;
    const bf16_t* Kg = p.K + (size_t)bh * SEQ * 96;
    const bf16_t* Vg = p.VT + (size_t)bh * 64 * SEQ;
    bf16x8 qf[6];
    {
        const bf16_t* qp = p.Q + ((size_t)bh * SEQ + q0w + l31) * 96 + 8 * hh;
#pragma unroll
        for (int s = 0; s < 6; ++s) qf[s] = *(const bf16x8*)(qp + 16 * s);
    }
    f32x16 O[2];
#pragma unroll
    for (int d = 0; d < 2; ++d)
#pragma unroll
        for (int r = 0; r < 16; ++r) O[d][r] = 0.f;
    float m = -1e30f, l = 0.f;
    const int ntiles = 2 * qt + 2;
    u32x4 kreg[3], vreg[2];
    const int vdv = tid >> 3, vkc = tid & 7;
#define ATT_GLOAD(j) { \
        _Pragma("unroll") for (int i = 0; i < 3; ++i) kreg[i] = *(const u32x4*)(Kg + (size_t)(j) * 64 * 96 + (tid + 256 * i) * 8); \
        _Pragma("unroll") for (int i = 0; i < 2; ++i) vreg[i] = *(const u32x4*)(Vg + (size_t)(vdv + 32 * i) * SEQ + (j) * 64 + vkc * 8); }
#define ATT_LSTORE(buf) { \
        _Pragma("unroll") for (int i = 0; i < 3; ++i) { const int c = tid + 256 * i; *(u32x4*)(lds + (buf) * KB + (c / 12) * KR + (c % 12) * 16) = kreg[i]; } \
        _Pragma("unroll") for (int i = 0; i < 2; ++i) *(u32x4*)(lds + VOFF + (buf) * VB + (vdv + 32 * i) * LROW + vkc * 16) = vreg[i]; }
    __syncthreads();
    ATT_GLOAD(0);
    ATT_LSTORE(0);
    if (ntiles > 1) ATT_GLOAD(1);
    __syncthreads();
    for (int j = 0; j < ntiles; ++j) {
        const int kv0 = 64 * j;
        if (kv0 <= q0w + 31) {
            const char* Kb = lds + (j & 1) * KB + l31 * KR + hh * 16;
            const char* Vb = lds + VOFF + (j & 1) * VB + l31 * LROW + hh * 16;
            f32x16 sc[2];
            bf16x8 kf[2][6], vf[2][4];
#pragma unroll
            for (int kb = 0; kb < 2; ++kb)
#pragma unroll
                for (int s = 0; s < 6; ++s) kf[kb][s] = *(const bf16x8*)(Kb + kb * 32 * KR + s * 32);
            __builtin_amdgcn_sched_barrier(0);
#pragma unroll
            for (int kb = 0; kb < 2; ++kb)
#pragma unroll
                for (int r = 0; r < 16; ++r) sc[kb][r] = 0.f;
#pragma unroll
            for (int s = 0; s < 6; ++s)
#pragma unroll
                for (int kb = 0; kb < 2; ++kb) sc[kb] = mfma(kf[kb][s], qf[s], sc[kb]);
#pragma unroll
            for (int d = 0; d < 2; ++d)
#pragma unroll
                for (int ks = 0; ks < 4; ++ks) vf[d][ks] = *(const bf16x8*)(Vb + d * 32 * LROW + ks * 32);
            __builtin_amdgcn_sched_barrier(0);
            if (kv0 + 63 > q0w) {
                const int qi = q0w + l31;
#pragma unroll
                for (int kb = 0; kb < 2; ++kb)
#pragma unroll
                    for (int r = 0; r < 16; ++r) { const int key = kv0 + 32 * kb + crow(r, hh); if (key > qi) sc[kb][r] = -1e30f; }
            }
            if (FIXED) {
                f32x2 rs2 = {0.f, 0.f};
#pragma unroll
                for (int kb = 0; kb < 2; ++kb)
#pragma unroll
                    for (int r = 0; r < 16; r += 2) { const float p0 = fexp2(sc[kb][r]), p1 = fexp2(sc[kb][r + 1]); sc[kb][r] = p0; sc[kb][r + 1] = p1; rs2 += (f32x2){p0, p1}; }
                l += rs2.x + rs2.y;
            } else {
            float mx = -1e30f;
#pragma unroll
            for (int kb = 0; kb < 2; ++kb)
#pragma unroll
                for (int r = 0; r < 16; ++r) mx = fmaxf(mx, sc[kb][r]);
            mx = fmaxf(mx, __shfl_xor(mx, 32));
            const float mn = fmaxf(m, mx), alpha = fexp2(m - mn);
            m = mn;
            float rsum = 0.f;
#pragma unroll
            for (int kb = 0; kb < 2; ++kb)
#pragma unroll
                for (int r = 0; r < 16; ++r) { const float pv = fexp2(sc[kb][r] - mn); sc[kb][r] = pv; rsum += pv; }
            l = l * alpha + rsum;
#pragma unroll
            for (int d = 0; d < 2; ++d)
#pragma unroll
                for (int r = 0; r < 16; ++r) O[d][r] *= alpha;
            }
#pragma unroll
            for (int kb = 0; kb < 2; ++kb)
#pragma unroll
                for (int sp = 0; sp < 2; ++sp) {
                    u32x4 w;
                    w.x = pk(sc[kb][8 * sp], sc[kb][8 * sp + 1]); w.y = pk(sc[kb][8 * sp + 2], sc[kb][8 * sp + 3]);
                    w.z = pk(sc[kb][8 * sp + 4], sc[kb][8 * sp + 5]); w.w = pk(sc[kb][8 * sp + 6], sc[kb][8 * sp + 7]);
                    const bf16x8 pf = __builtin_bit_cast(bf16x8, w);
#pragma unroll
                    for (int d = 0; d < 2; ++d) O[d] = mfma(vf[d][2 * kb + sp], pf, O[d]);
                }
        }
        if (j + 1 < ntiles) {
            ATT_LSTORE((j + 1) & 1);
            if (j + 2 < ntiles) ATT_GLOAD(j + 2);
        }
        __syncthreads();
    }
#undef ATT_GLOAD
#undef ATT_LSTORE
    l += __shfl_xor(l, 32);
    const float inv = 1.0f / l;
    const int head = bh & 7, bidx = bh >> 3;
    const int t = bidx * SEQ + q0w + l31;
    float ss = 0.f;
#pragma unroll
    for (int d = 0; d < 2; ++d)
#pragma unroll
        for (int gq = 0; gq < 4; ++gq) {
            const int dv = 32 * d + 8 * gq + 4 * hh;
            const u32x2 z = *(const u32x2*)(p.proj + (size_t)t * NIN + C_ZM + head * 64 + dv);
            const float v0 = O[d][4 * gq] * inv * siluf_(bflo(z.x)), v1 = O[d][4 * gq + 1] * inv * siluf_(bfhi(z.x));
            const float v2 = O[d][4 * gq + 2] * inv * siluf_(bflo(z.y)), v3 = O[d][4 * gq + 3] * inv * siluf_(bfhi(z.y));
            ss += v0 * v0 + v1 * v1 + v2 * v2 + v3 * v3;
            u32x2 w; w.x = pk(v0, v1); w.y = pk(v2, v3);
            *(u32x2*)(p.Y + (size_t)t * 1024 + head * 64 + dv) = w;
        }
    (void)ss;
}

DI void phase_attn(const Params& p, int layer, char* lds) {
    float gq = 0.f, gk = 0.f;
    for (int i = 0; i < 96; ++i) { gq = fmaxf(gq, fabsf(p.qk_q_g[layer * 96 + i])); gk = fmaxf(gk, fabsf(p.qk_k_g[layer * 96 + i])); }
    const bool fixed_ok = 96.0f * gq * gk * (0.10206207261596577f * 1.4426950408889634f) < 40.0f;
    for (int item = blockIdx.x; item < 256; item += gridDim.x) conv_item(p, layer, item, lds);
    for (int item = blockIdx.x; item < 512; item += gridDim.x) {
        const int bh = 2 * (item & 7) + (item >> 8), i = (item >> 3) & 31;
        if (fixed_ok) { attn_qtile<true>(p, bh, 63 - i, lds); attn_qtile<true>(p, bh, i, lds); }
        else { attn_qtile<false>(p, bh, 63 - i, lds); attn_qtile<false>(p, bh, i, lds); }
    }
    for (int item = gridDim.x - 1 - blockIdx.x; item < 128; item += gridDim.x) sgu_item(p, layer, item, lds);
}

DI void phase_norm(const Params& p) {
    const int lane = threadIdx.x & 63, wave = threadIdx.x >> 6;
    for (int t0 = (blockIdx.x * 4 + wave) * 4; t0 < NT; t0 += gridDim.x * 16) {
        u32x4 m[4]; u32x2 g[4];
#pragma unroll
        for (int r = 0; r < 4; ++r) { const bf16_t* row = p.Y + (size_t)(t0 + r) * 1024; m[r] = *(const u32x4*)(row + 8 * lane); g[r] = *(const u32x2*)(row + 512 + 4 * lane); }
        float sm[4], sg[4];
#pragma unroll
        for (int r = 0; r < 4; ++r) {
            sm[r] = 0.f; sg[r] = 0.f;
#pragma unroll
            for (int e = 0; e < 4; ++e) { const float a = bflo(m[r][e]), b = bfhi(m[r][e]); sm[r] += a * a + b * b; }
#pragma unroll
            for (int e = 0; e < 2; ++e) { const float a = bflo(g[r][e]), b = bfhi(g[r][e]); sg[r] += a * a + b * b; }
        }
#pragma unroll
        for (int o = 32; o >= 1; o >>= 1)
#pragma unroll
            for (int r = 0; r < 4; ++r) { sm[r] += __shfl_xor(sm[r], o); sg[r] += __shfl_xor(sg[r], o); }
#pragma unroll
        for (int r = 0; r < 4; ++r) {
            const float rm = rsqrtf(sm[r] * (1.0f / 512.0f) + EPS), rg = rsqrtf(sg[r] * (1.0f / 256.0f) + EPS);
            u32x4 mo; u32x2 go;
#pragma unroll
            for (int e = 0; e < 4; ++e) mo[e] = pk(bflo(m[r][e]) * rm, bfhi(m[r][e]) * rm);
#pragma unroll
            for (int e = 0; e < 2; ++e) go[e] = pk(bflo(g[r][e]) * rg, bfhi(g[r][e]) * rg);
            bf16_t* row = p.Y + (size_t)(t0 + r) * 1024;
            *(u32x4*)(row + 8 * lane) = mo;
            *(u32x2*)(row + 512 + 4 * lane) = go;
        }
    }
}

DI void phase_out(const Params& p, int layer, char* lds) {
    const int lane = otid() & 63, wave = otid() >> 6, l31 = lane & 31, hh = lane >> 5;
    const float* xin = layer == 0 ? p.x : p.out;
    const bf16_t* W = p.WoutT + (size_t)layer * 1024 * 1024;
    for (int item = blockIdx.x; item < 512; item += gridDim.x) {
        const int x = item & 7, j = item >> 3, tt = 8 * x + (j >> 3), ft = j & 7;
        f32x16 acc[4][2]; zero_acc(acc);
        const bf16_t* Wt = W + (size_t)ft * 128 * 1024;
        const bf16_t* Yt = p.Y + (size_t)tt * 256 * 1024;
        gemm_tile<4, 2>(Wt, 1024, Yt, 1024, 1024, lds, acc);
        {
            char* wl = lds + wave * (32 * 528);
            const int c = lane & 31, rh = lane >> 5;
            __syncthreads();
#pragma unroll
            for (int tb = 0; tb < 2; ++tb) {
                const int tw = tt * 256 + wave * 64 + tb * 32;
#pragma unroll
                for (int fb = 0; fb < 4; ++fb)
#pragma unroll
                    for (int gq = 0; gq < 4; ++gq) {
                        f32x4 v; v.x = acc[fb][tb][4 * gq]; v.y = acc[fb][tb][4 * gq + 1]; v.z = acc[fb][tb][4 * gq + 2]; v.w = acc[fb][tb][4 * gq + 3];
                        *(f32x4*)(wl + l31 * 528 + (32 * fb + 8 * gq + 4 * hh) * 4) = v;
                    }
#pragma unroll 4
                for (int i = 0; i < 16; ++i) {
                    const int row = 2 * i + rh, t = tw + row, f = ft * 128 + 4 * c;
                    const f32x4 v = *(const f32x4*)(wl + row * 528 + c * 16);
                    f32x4 xv = *(const f32x4*)(xin + (size_t)t * 1024 + f);
                    xv.x += v.x; xv.y += v.y; xv.z += v.z; xv.w += v.w;
                    *(f32x4*)(p.out + (size_t)t * 1024 + f) = xv;
                    if (layer == 0) {
                        u32x2 w; w.x = pk(xv.x, xv.y); w.y = pk(xv.z, xv.w);
                        *(u32x2*)(p.xb + (size_t)t * 1024 + f) = w;
                        float ss = xv.x * xv.x + xv.y * xv.y + xv.z * xv.z + xv.w * xv.w;
                        ss += __shfl_xor(ss, 16); ss += __shfl_xor(ss, 8); ss += __shfl_xor(ss, 4); ss += __shfl_xor(ss, 2); ss += __shfl_xor(ss, 1);
                        if (c == 0) p.ss_x[t * 8 + ft] = ss;
                    }
                }
            }
        }
    }
}


#define XB_TMO      128
#define XB_XCNT(j)  (256  + 64 * (j))
#define XB_XSUB(j)  (1280 + 64 * (j))
#define XB_XGEN(j)  (2304 + 64 * (j))
#define XB_TOP      3328
#define XB_TOPGEN   3392
#define XCD_BAR_WORDS 3456
#define XB_SPIN_CAP (1u << 20)
#define LAS __attribute__((address_space(3)))
DI unsigned xb_ld(unsigned* p)              { return __hip_atomic_load(p, __ATOMIC_RELAXED, __HIP_MEMORY_SCOPE_AGENT); }
DI unsigned xb_add(unsigned* p, unsigned v) { return __hip_atomic_fetch_add(p, v, __ATOMIC_RELAXED, __HIP_MEMORY_SCOPE_AGENT); }
DI unsigned xb_xcc_id() { return (unsigned)__builtin_amdgcn_s_getreg((3 << 11) | 20) & 0xFu; }
#define XB_SPIN(cond, bar) do { unsigned _sp = 0; while (cond) { __builtin_amdgcn_s_sleep(1); \
    if ((++_sp & 255u) == 0u) { if (xb_ld(&(bar)[XB_TMO])) break; if (_sp > XB_SPIN_CAP) { atomicAdd(&(bar)[XB_TMO], 1u); break; } } } } while (0)
struct XcdBarrier { unsigned* bar; unsigned x; volatile LAS unsigned* st; };
DI XcdBarrier xcd_barrier_post(unsigned* bar, volatile LAS unsigned* st) {
    XcdBarrier b; b.bar = bar; b.x = xb_xcc_id(); b.st = st;
    if (threadIdx.x == 0) (void)xb_add(&bar[XB_XCNT(b.x)], 1u);
    return b;
}
DI void xcd_barrier_complete(unsigned* bar, unsigned x, unsigned& nloc, unsigned& nx) {
    const unsigned G = gridDim.x * gridDim.y * gridDim.z;
    unsigned sum, cnt, mine, sp = 0u;
    for (;;) {
        sum = 0u; cnt = 0u; mine = 0u;
#pragma unroll
        for (unsigned j = 0; j < 16; ++j) { const unsigned c = xb_ld(&bar[XB_XCNT(j)]); sum += c; cnt += (c > 0u) ? 1u : 0u; mine = (j == x) ? c : mine; }
        if (sum == G) break;
        __builtin_amdgcn_s_sleep(1);
        if ((++sp & 255u) == 0u) { if (xb_ld(&bar[XB_TMO])) break; if (sp > XB_SPIN_CAP) { atomicAdd(&bar[XB_TMO], 1u); break; } }
    }
    nloc = mine > 0u ? mine : 1u; nx = cnt > 0u ? cnt : 1u;
}
DI void xcd_barrier(const XcdBarrier& b) {
    asm volatile("s_waitcnt vmcnt(0)" ::: "memory");
    __syncthreads();
    if (threadIdx.x == 0) {
        unsigned* bar = b.bar;
        __builtin_amdgcn_s_waitcnt(0);
        unsigned nloc = b.st[0], nx = b.st[1];
        if (nloc == 0u) { xcd_barrier_complete(bar, b.x, nloc, nx); b.st[0] = nloc; b.st[1] = nx; }
        const unsigned old = xb_add(&bar[XB_XSUB(b.x)], 1u);
        const unsigned gen = old / nloc;
        if (old + 1u == (gen + 1u) * nloc) {
            __builtin_amdgcn_fence(__ATOMIC_RELEASE, "agent");
            asm volatile("s_waitcnt vmcnt(0)" ::: "memory");
            const unsigned og = xb_add(&bar[XB_TOP], 1u);
            const unsigned tg = og / nx;
            if (og + 1u == (tg + 1u) * nx) xb_add(&bar[XB_TOPGEN], 1u);
            else XB_SPIN(xb_ld(&bar[XB_TOPGEN]) == tg, bar);
            __builtin_amdgcn_fence(__ATOMIC_ACQUIRE, "agent");
            xb_add(&bar[XB_XGEN(b.x)], 1u);
            asm volatile("s_waitcnt vmcnt(0)" ::: "memory");
        } else {
            XB_SPIN(xb_ld(&bar[XB_XGEN(b.x)]) == gen, bar);
            __builtin_amdgcn_fence(__ATOMIC_ACQUIRE, "agent");
            asm volatile("s_waitcnt vmcnt(0)" ::: "memory");
        }
    }
    __syncthreads();
}
#if MK_LAUNCHES == 1
DI void gsync() {
    asm volatile("s_waitcnt vmcnt(0)" ::: "memory");
    cg::this_grid().sync();
}
__global__ void __launch_bounds__(256, 2) mega_kernel(Params p) {
    __shared__ __attribute__((aligned(16))) char lds[LDS_BYTES];
    __shared__ uint4 xb_words;
    if (threadIdx.x == 0) xb_words = make_uint4(0u, 0u, 0u, 0u);
    __syncthreads();
    for (int i = blockIdx.x * 256 + threadIdx.x; i < XCD_BAR_WORDS + 64; i += gridDim.x * 256) p.bar[i] = 0u;
    gsync();
    if (threadIdx.x == 0) (void)xb_add(&p.bar[XB_XCNT(xb_xcc_id())], 1u);
    phase0(p, lds);
    XcdBarrier xb; xb.bar = p.bar; xb.x = xb_xcc_id(); xb.st = (volatile LAS unsigned*)&xb_words;
    xcd_barrier(xb);
#pragma unroll 1
    for (int layer = 0; layer < 2; ++layer) {
        phase_inproj(p, layer, lds);
        xcd_barrier(xb);
        phase_pre(p, layer, lds);
        xcd_barrier(xb);
        phase_attn(p, layer, lds);
        xcd_barrier(xb);
        phase_norm(p);
        xcd_barrier(xb);
        phase_out(p, layer, lds);
        if (layer == 0) xcd_barrier(xb);
    }
}
#endif

extern "C" void kernel_launch(void* const* d_in, const int* in_sizes, int n_in, void* d_out, int out_size, void* d_ws, size_t ws_size, hipStream_t stream) {
    Params p{};
    p.x = (const float*)d_in[0]; p.norm_g = (const float*)d_in[1]; p.w_in = (const float*)d_in[2]; p.conv_w = (const float*)d_in[3];
    p.conv_b = (const float*)d_in[4]; p.conv_ln_g = (const float*)d_in[5]; p.conv_ln_b = (const float*)d_in[6]; p.conv_pw_w = (const float*)d_in[7];
    p.conv_pw_b = (const float*)d_in[8]; p.q_norm_g = (const float*)d_in[9]; p.w_uq = (const float*)d_in[10]; p.kv_norm_g = (const float*)d_in[11];
    p.w_ukv = (const float*)d_in[12]; p.qk_q_g = (const float*)d_in[13]; p.qk_k_g = (const float*)d_in[14]; p.sg_ln_g = (const float*)d_in[15];
    p.sg_ln_b = (const float*)d_in[16]; p.sg_w = (const float*)d_in[17]; p.sg_b = (const float*)d_in[18]; p.branch_norm_g = (const float*)d_in[19];
    p.w_out = (const float*)d_in[20];
    p.out = (float*)d_out;
    char* ws = (char*)d_ws; size_t off = 0;
    auto take = [&](size_t bytes) { char* r = ws + off; off += (bytes + 255) & ~(size_t)255; return r; };
    p.proj = (bf16_t*)take((size_t)NT * NIN * 2);
    p.xb = (bf16_t*)take((size_t)NT * 1024 * 2);
    p.Q = (bf16_t*)take((size_t)16 * SEQ * 96 * 2);
    p.K = (bf16_t*)take((size_t)16 * SEQ * 96 * 2);
    p.VT = (bf16_t*)take((size_t)16 * 64 * SEQ * 2);
    p.Y = (bf16_t*)take((size_t)NT * 1024 * 2);
    p.WinT = (bf16_t*)take((size_t)2 * 3104 * 1024 * 2);
    p.WuqT = (bf16_t*)take((size_t)2 * 768 * 768 * 2);
    p.WukvT = (bf16_t*)take((size_t)2 * 1024 * 256 * 2);
    p.PwT = (bf16_t*)take((size_t)2 * 256 * 256 * 2);
    p.WoutT = (bf16_t*)take((size_t)2 * 1024 * 1024 * 2);
    p.SgW = (bf16_t*)take((size_t)2 * 4 * 128 * 128 * 2);
    p.ss_x = (float*)take((size_t)NT * 8 * 4);
    p.ss_p = (float*)take((size_t)NT * 8 * 4);
    p.ss_m = (float*)take((size_t)NT * 8 * 4);
    p.ss_s = (float*)take((size_t)NT * 4);
    p.rope = (float*)take((size_t)SEQ * 32 * 4);
    p.bar = (unsigned*)take(16384);
    for (int i = 0; i < 16; ++i) p.invf[i] = powf(10000.0f, -(float)i / 16.0f);
    if (off > ws_size) { fprintf(stderr, "workspace too small: need %zu have %zu\n", off, ws_size); return; }
#if MK_LAUNCHES == 1
    static int grid_blocks = 0;
    if (!grid_blocks) {
        int dev = 0, cus = 0, per_cu = 0;
        hipGetDevice(&dev);
        hipDeviceGetAttribute(&cus, hipDeviceAttributeMultiprocessorCount, dev);
        hipOccupancyMaxActiveBlocksPerMultiprocessor(&per_cu, mega_kernel, 256, 0);
        if (per_cu > 2) per_cu = 2;
        grid_blocks = cus * per_cu;
    }
    void* args[] = {&p};
    hipError_t e = hipLaunchCooperativeKernel((void*)mega_kernel, dim3(grid_blocks), dim3(256), args, 0, stream);
    if (e != hipSuccess) fprintf(stderr, "cooperative launch failed: %s (grid %d)\n", hipGetErrorString(e), grid_blocks);
#endif
}
```

```cpp
#include <hip/hip_runtime.h>
#include <hip/hip_cooperative_groups.h>
#include <cstdio>
#include <cmath>
namespace cg = cooperative_groups;

#ifndef MK_LAUNCHES
#define MK_LAUNCHES 1
#endif

typedef unsigned short bf16_t;
typedef short bf16x8 __attribute__((ext_vector_type(8)));
typedef float f32x16 __attribute__((ext_vector_type(16)));
typedef float f32x4 __attribute__((ext_vector_type(4)));
typedef float f32x2 __attribute__((ext_vector_type(2)));
typedef __bf16 bf2_t __attribute__((ext_vector_type(2)));
typedef unsigned u32x4 __attribute__((ext_vector_type(4)));
typedef unsigned u32x2 __attribute__((ext_vector_type(2)));
#define DI __device__ __forceinline__

constexpr int NT = 16384, SEQ = 8192, NIN = 3104;
constexpr int C_A = 0, C_AG = 256, C_ZC = 512, C_CQ = 768, C_CKV = 1536, C_ZM = 1792, C_U = 2304, C_V = 2560, C_ZS = 2816, C_KR = 3072;
constexpr int LROW = 144;
constexpr int LDS_BYTES = 69632;
constexpr float EPS = 1e-6f;

struct Params {
    const float* x; const float* norm_g; const float* w_in; const float* conv_w; const float* conv_b;
    const float* conv_ln_g; const float* conv_ln_b; const float* conv_pw_w; const float* conv_pw_b;
    const float* q_norm_g; const float* w_uq; const float* kv_norm_g; const float* w_ukv;
    const float* qk_q_g; const float* qk_k_g; const float* sg_ln_g; const float* sg_ln_b;
    const float* sg_w; const float* sg_b; const float* branch_norm_g; const float* w_out;
    float* out;
    bf16_t* proj; bf16_t* xb; bf16_t* Q; bf16_t* K; bf16_t* VT; bf16_t* Y;
    bf16_t* WinT; bf16_t* WuqT; bf16_t* WukvT; bf16_t* PwT; bf16_t* WoutT; bf16_t* SgW;
    float* ss_x; float* ss_p; float* ss_m; float* ss_s; float* rope;
    float invf[16];
    unsigned* bar; unsigned long long pad_;
};

DI unsigned pk(float lo, float hi) { f32x2 v = {lo, hi}; return __builtin_bit_cast(unsigned, __builtin_convertvector(v, bf2_t)); }
DI float bflo(unsigned w) { return __uint_as_float(w << 16); }
DI float bfhi(unsigned w) { return __uint_as_float(w & 0xffff0000u); }
DI float fexp2(float x) { return __builtin_amdgcn_exp2f(x); }
DI float rcpf_(float x) { return __builtin_amdgcn_rcpf(x); }
DI float sigmoidf_(float x) { return rcpf_(1.0f + __expf(-x)); }
DI float siluf_(float x) { return x * rcpf_(1.0f + __expf(-x)); }
DI float geluf_(float x) { const float u = 0.7978845608028654f * (x + 0.044715f * x * x * x); return x * rcpf_(1.0f + __expf(-2.0f * u)); }
DI unsigned opaque0() { unsigned z = 0; asm volatile("" : "+v"(z)); return z; }
DI int otid() { return (int)(threadIdx.x + opaque0()); }
DI int crow(int reg, int h) { return (reg & 3) + 8 * (reg >> 2) + 4 * h; }
DI f32x16 mfma(bf16x8 a, bf16x8 b, f32x16 c) { return __builtin_amdgcn_mfma_f32_32x32x16_bf16(a, b, c, 0, 0, 0); }
DI float sum8(const float* p) { const f32x4 a = *(const f32x4*)p, b = *(const f32x4*)(p + 4); return (a.x + a.y) + (a.z + a.w) + (b.x + b.y) + (b.z + b.w); }

template <int NFB, int NTB>
DI void gemm_tile(const bf16_t* __restrict__ Wp, int ldw, const bf16_t* __restrict__ Tp, int ldt, int K, char* lds, f32x16 (&acc)[NFB][NTB]) {
    constexpr int WROWS = NFB * 32, WCH = NFB, TCH = NTB * 4;
    char* ldsW = lds; char* ldsT = lds + WROWS * LROW;
    const int tid = otid(), lane = tid & 63, wave = tid >> 6, l31 = lane & 31, hh = lane >> 5;
    const int cr = tid >> 3, ckc = tid & 7;
    u32x4 wreg[WCH], treg[TCH];
    const bf16_t* wsrc = Wp + (size_t)cr * ldw + ckc * 8;
    const bf16_t* tsrc = Tp + (size_t)cr * ldt + ckc * 8;
#pragma unroll
    for (int i = 0; i < WCH; ++i) wreg[i] = *(const u32x4*)(wsrc + (size_t)(32 * i) * ldw);
#pragma unroll
    for (int i = 0; i < TCH; ++i) treg[i] = *(const u32x4*)(tsrc + (size_t)(32 * i) * ldt);
    const int nk = K >> 6;
    char* wdst = ldsW + cr * LROW + ckc * 16;
    char* tdst = ldsT + cr * LROW + ckc * 16;
    const char* wfp = ldsW + l31 * LROW + hh * 16;
    const char* tfp = ldsT + (wave * NTB * 32 + l31) * LROW + hh * 16;
    for (int kt = 0; kt < nk; ++kt) {
        __syncthreads();
#pragma unroll
        for (int i = 0; i < WCH; ++i) *(u32x4*)(wdst + 32 * i * LROW) = wreg[i];
#pragma unroll
        for (int i = 0; i < TCH; ++i) *(u32x4*)(tdst + 32 * i * LROW) = treg[i];
        __syncthreads();
        if (kt + 1 < nk) {
            const int ko = (kt + 1) * 64;
#pragma unroll
            for (int i = 0; i < WCH; ++i) wreg[i] = *(const u32x4*)(wsrc + (size_t)(32 * i) * ldw + ko);
#pragma unroll
            for (int i = 0; i < TCH; ++i) treg[i] = *(const u32x4*)(tsrc + (size_t)(32 * i) * ldt + ko);
        }
#pragma unroll
        for (int s = 0; s < 4; ++s) {
            bf16x8 wf[NFB], tf[NTB];
#pragma unroll
            for (int fb = 0; fb < NFB; ++fb) wf[fb] = *(const bf16x8*)(wfp + fb * 32 * LROW + s * 32);
#pragma unroll
            for (int tb = 0; tb < NTB; ++tb) tf[tb] = *(const bf16x8*)(tfp + tb * 32 * LROW + s * 32);
#pragma unroll
            for (int fb = 0; fb < NFB; ++fb)
#pragma unroll
                for (int tb = 0; tb < NTB; ++tb) acc[fb][tb] = mfma(wf[fb], tf[tb], acc[fb][tb]);
        }
    }
}

template <int NFB, int NTB>
DI void gemm_issue(const bf16_t* __restrict__ Wp, int ldw, const bf16_t* __restrict__ Tp, int ldt, u32x4 (&wreg)[NFB], u32x4 (&treg)[NTB * 4]) {
    const int tid = otid(), cr = tid >> 3, ckc = tid & 7;
    const bf16_t* wsrc = Wp + (size_t)cr * ldw + ckc * 8;
    const bf16_t* tsrc = Tp + (size_t)cr * ldt + ckc * 8;
#pragma unroll
    for (int i = 0; i < NFB; ++i) wreg[i] = *(const u32x4*)(wsrc + (size_t)(32 * i) * ldw);
#pragma unroll
    for (int i = 0; i < NTB * 4; ++i) treg[i] = *(const u32x4*)(tsrc + (size_t)(32 * i) * ldt);
}
template <int NFB>
DI void gemm_issue_w(const bf16_t* __restrict__ Wp, int ldw, u32x4 (&wreg)[NFB]) {
    const int tid = otid(), cr = tid >> 3, ckc = tid & 7;
    const bf16_t* wsrc = Wp + (size_t)cr * ldw + ckc * 8;
#pragma unroll
    for (int i = 0; i < NFB; ++i) wreg[i] = *(const u32x4*)(wsrc + (size_t)(32 * i) * ldw);
}
template <int NTB>
DI void gemm_issue_t(const bf16_t* __restrict__ Tp, int ldt, u32x4 (&treg)[NTB * 4]) {
    const int tid = otid(), cr = tid >> 3, ckc = tid & 7;
    const bf16_t* tsrc = Tp + (size_t)cr * ldt + ckc * 8;
#pragma unroll
    for (int i = 0; i < NTB * 4; ++i) treg[i] = *(const u32x4*)(tsrc + (size_t)(32 * i) * ldt);
}
template <int NFB, int NTB>
DI void gemm_run(const bf16_t* __restrict__ Wp, int ldw, const bf16_t* __restrict__ Tp, int ldt, int K, char* lds, f32x16 (&acc)[NFB][NTB],
                 u32x4 (&wreg)[NFB], u32x4 (&treg)[NTB * 4]) {
    constexpr int WROWS = NFB * 32, WCH = NFB, TCH = NTB * 4;
    char* ldsW = lds; char* ldsT = lds + WROWS * LROW;
    const int tid = otid(), lane = tid & 63, wave = tid >> 6, l31 = lane & 31, hh = lane >> 5;
    const int cr = tid >> 3, ckc = tid & 7;
    const bf16_t* wsrc = Wp + (size_t)cr * ldw + ckc * 8;
    const bf16_t* tsrc = Tp + (size_t)cr * ldt + ckc * 8;
    const int nk = K >> 6;
    char* wdst = ldsW + cr * LROW + ckc * 16;
    char* tdst = ldsT + cr * LROW + ckc * 16;
    const char* wfp = ldsW + l31 * LROW + hh * 16;
    const char* tfp = ldsT + (wave * NTB * 32 + l31) * LROW + hh * 16;
    for (int kt = 0; kt < nk; ++kt) {
        __syncthreads();
#pragma unroll
        for (int i = 0; i < WCH; ++i) *(u32x4*)(wdst + 32 * i * LROW) = wreg[i];
#pragma unroll
        for (int i = 0; i < TCH; ++i) *(u32x4*)(tdst + 32 * i * LROW) = treg[i];
        __syncthreads();
        if (kt + 1 < nk) {
            const int ko = (kt + 1) * 64;
#pragma unroll
            for (int i = 0; i < WCH; ++i) wreg[i] = *(const u32x4*)(wsrc + (size_t)(32 * i) * ldw + ko);
#pragma unroll
            for (int i = 0; i < TCH; ++i) treg[i] = *(const u32x4*)(tsrc + (size_t)(32 * i) * ldt + ko);
        }
#pragma unroll
        for (int s = 0; s < 4; ++s) {
            bf16x8 wf[NFB], tf[NTB];
#pragma unroll
            for (int fb = 0; fb < NFB; ++fb) wf[fb] = *(const bf16x8*)(wfp + fb * 32 * LROW + s * 32);
#pragma unroll
            for (int tb = 0; tb < NTB; ++tb) tf[tb] = *(const bf16x8*)(tfp + tb * 32 * LROW + s * 32);
#pragma unroll
            for (int fb = 0; fb < NFB; ++fb)
#pragma unroll
                for (int tb = 0; tb < NTB; ++tb) acc[fb][tb] = mfma(wf[fb], tf[tb], acc[fb][tb]);
        }
    }
}

template <int NFB, int NTB> DI void zero_acc(f32x16 (&acc)[NFB][NTB]) {
#pragma unroll
    for (int a = 0; a < NFB; ++a)
#pragma unroll
        for (int b = 0; b < NTB; ++b)
#pragma unroll
            for (int r = 0; r < 16; ++r) acc[a][b][r] = 0.f;
}

DI void tconv_tile(const float* __restrict__ src, int ldsrc, int ks, int ns, int nvalid, const float* __restrict__ scale,
                   bf16_t* __restrict__ dst, int lddst, int kd, int nd, float* tile) {
    const int tid = threadIdx.x;
    __syncthreads();
    {
        const int n = tid & 63, kk = tid >> 6;
        float v[16];
#pragma unroll
        for (int r = 0; r < 16; ++r) v[r] = (n < nvalid) ? src[(size_t)(ks + r * 4 + kk) * ldsrc + ns + n] : 0.f;
        if (scale) {
#pragma unroll
            for (int r = 0; r < 16; ++r) v[r] *= scale[ks + r * 4 + kk];
        }
#pragma unroll
        for (int r = 0; r < 16; ++r) tile[(r * 4 + kk) * 65 + n] = v[r];
    }
    __syncthreads();
    {
        const int n = tid >> 2, kq = tid & 3;
        if (n < nvalid) {
            const float* tp = tile + (kq * 16) * 65 + n;
            u32x4 a, b;
            a.x = pk(tp[0 * 65], tp[1 * 65]);  a.y = pk(tp[2 * 65], tp[3 * 65]);   a.z = pk(tp[4 * 65], tp[5 * 65]);   a.w = pk(tp[6 * 65], tp[7 * 65]);
            b.x = pk(tp[8 * 65], tp[9 * 65]);  b.y = pk(tp[10 * 65], tp[11 * 65]); b.z = pk(tp[12 * 65], tp[13 * 65]); b.w = pk(tp[14 * 65], tp[15 * 65]);
            bf16_t* d = dst + (size_t)(nd + n) * lddst + kd + kq * 16;
            *(u32x4*)d = a; *(u32x4*)(d + 8) = b;
        }
    }
}

DI void phase0(const Params& p, char* lds) {
    float* tile = (float*)lds;
    const int tid = threadIdx.x, lane = tid & 63, wave = tid >> 6;
    for (int item = blockIdx.x; item < 2 * 1264; item += gridDim.x) {
        const int layer = item / 1264; int id = item % 1264;
        if (id < 784) {
            const int kt = id & 15, nt = id >> 4, nd = nt * 64;
            int ns, nv = 64;
            if (nd < 1792) ns = nd; else if (nd < 3072) ns = nd + 32; else { ns = 1792; nv = 32; }
            tconv_tile(p.w_in + (size_t)layer * 1024 * 3104, 3104, kt * 64, ns, nv, p.norm_g + layer * 1024,
                       p.WinT + (size_t)layer * 3104 * 1024, 1024, kt * 64, nd, tile);
        } else if ((id -= 784) < 144) {
            const int kt = id % 12, nt = id / 12;
            tconv_tile(p.w_uq + (size_t)layer * 768 * 768, 768, kt * 64, nt * 64, 64, p.q_norm_g + layer * 768,
                       p.WuqT + (size_t)layer * 768 * 768, 768, kt * 64, nt * 64, tile);
        } else if ((id -= 144) < 64) {
            const int kt = id & 3, nt = id >> 2;
            tconv_tile(p.w_ukv + (size_t)layer * 256 * 1024, 1024, kt * 64, nt * 64, 64, p.kv_norm_g + layer * 256,
                       p.WukvT + (size_t)layer * 1024 * 256, 256, kt * 64, nt * 64, tile);
        } else if ((id -= 64) < 16) {
            const int kt = id & 3, nt = id >> 2;
            tconv_tile(p.conv_pw_w + (size_t)layer * 256 * 256, 256, kt * 64, nt * 64, 64, nullptr,
                       p.PwT + (size_t)layer * 256 * 256, 256, kt * 64, nt * 64, tile);
        } else {
            id -= 16;
            const int kt = id & 15, nt = id >> 4, kd = kt * 64;
            const int ks = kd < 768 ? kd + 256 : kd - 768;
            tconv_tile(p.w_out + (size_t)layer * 1024 * 1024, 1024, ks, nt * 64, 64, p.branch_norm_g + layer * 1024,
                       p.WoutT + (size_t)layer * 1024 * 1024, 1024, kd, nt * 64, tile);
        }
    }
    const int gtid = blockIdx.x * 256 + tid, nthr = gridDim.x * 256;
    for (int e = gtid; e < 2 * 4 * 128 * 128; e += nthr) {
        const int t = (e >> 7) & 127, s = e & 127;
        p.SgW[e] = (bf16_t)(s <= t ? (pk(p.sg_w[e], 0.f) & 0xffffu) : 0u);
    }
    for (int e = gtid; e < SEQ * 16; e += nthr) {
        const int pos = e >> 4, i = e & 15;
        const float ang = (float)pos * p.invf[i];
        const double rev = (double)ang * 0.15915494309189535;
        const float fr = (float)(rev - floor(rev));
        p.rope[pos * 32 + i] = __builtin_amdgcn_cosf(fr);
        p.rope[pos * 32 + 16 + i] = __builtin_amdgcn_sinf(fr);
    }
    for (int row = (blockIdx.x * 4 + wave) * 2; row < NT; row += gridDim.x * 8) {
        f32x4 v[2][4];
#pragma unroll
        for (int rr = 0; rr < 2; ++rr)
#pragma unroll
            for (int i = 0; i < 4; ++i) v[rr][i] = ((const f32x4*)(p.x + (size_t)(row + rr) * 1024))[lane + 64 * i];
#pragma unroll
        for (int rr = 0; rr < 2; ++rr)
#pragma unroll
            for (int i = 0; i < 4; ++i) {
                const f32x4 a = v[rr][i];
                float ss = a.x * a.x + a.y * a.y + a.z * a.z + a.w * a.w;
                u32x2 w; w.x = pk(a.x, a.y); w.y = pk(a.z, a.w);
                *(u32x2*)(p.xb + (size_t)(row + rr) * 1024 + 4 * (lane + 64 * i)) = w;
                ss += __shfl_xor(ss, 16); ss += __shfl_xor(ss, 8); ss += __shfl_xor(ss, 4); ss += __shfl_xor(ss, 2); ss += __shfl_xor(ss, 1);
                if ((lane & 31) == 0) p.ss_x[(row + rr) * 8 + 2 * i + (lane >> 5)] = ss;
            }
    }
}

template <int NFB>
DI void epi_inproj(const Params& p, f32x16 (&acc)[NFB][2], int tok0, int col0, int ssslot, char* lds) {
    __builtin_amdgcn_sched_barrier(0);
    const int lane = otid() & 63, wave = otid() >> 6, l31 = lane & 31, hh = lane >> 5;
    constexpr int RB = NFB * 64 + 16;
    constexpr int CH = NFB * 4;
    constexpr int RPP = 64 / CH;
    char* wl = lds + wave * (32 * RB);
    __syncthreads();
#pragma unroll
    for (int tb = 0; tb < 2; ++tb) {
        const int tw = tok0 + wave * 64 + tb * 32;
        const int t = tw + l31;
        const float r = rsqrtf(sum8(p.ss_x + t * 8) * (1.0f / 1024.0f) + EPS);
        float ss = 0.f;
#pragma unroll
        for (int fb = 0; fb < NFB; ++fb)
#pragma unroll
            for (int g = 0; g < 4; ++g) {
                const float v0 = acc[fb][tb][4 * g] * r, v1 = acc[fb][tb][4 * g + 1] * r, v2 = acc[fb][tb][4 * g + 2] * r, v3 = acc[fb][tb][4 * g + 3] * r;
                ss += v0 * v0 + v1 * v1 + v2 * v2 + v3 * v3;
                u32x2 w; w.x = pk(v0, v1); w.y = pk(v2, v3);
                *(u32x2*)(wl + l31 * RB + (32 * fb + 8 * g + 4 * hh) * 2) = w;
            }
        if (ssslot >= 0) { ss += __shfl_xor(ss, 32); if (hh == 0) p.ss_p[t * 8 + ssslot] = ss; }
        const int rr = lane / CH, cc = lane % CH;
#pragma unroll
        for (int i = 0; i < 32 / RPP; ++i) {
            const int row = rr + RPP * i;
            const u32x4 w = *(const u32x4*)(wl + row * RB + cc * 16);
            *(u32x4*)(p.proj + (size_t)(tw + row) * NIN + col0 + 8 * cc) = w;
        }
    }
}

DI void phase_inproj(const Params& p, int layer, char* lds) {
    const bf16_t* W = p.WinT + (size_t)layer * 3104 * 1024;
    u32x4 wreg[4], treg[8];
    int item = blockIdx.x;
    int tt = 0, ft = 0;
    if (item < 1536) {
        const int r = item >> 9, b = item & 511, x = b & 7, j = b >> 3;
        tt = 8 * x + (j >> 3); ft = 8 * r + (j & 7);
        gemm_issue<4, 2>(W + (size_t)ft * 128 * 1024, 1024, p.xb + (size_t)tt * 256 * 1024, 1024, wreg, treg);
    }
    while (item < 1536) {
        f32x16 acc[4][2]; zero_acc(acc);
        gemm_run<4, 2>(W + (size_t)ft * 128 * 1024, 1024, p.xb + (size_t)tt * 256 * 1024, 1024, 1024, lds, acc, wreg, treg);
        const int ctt = tt, cft = ft;
        item += gridDim.x;
        if (item < 1536) {
            const int r = item >> 9, b = item & 511, x = b & 7, j = b >> 3;
            tt = 8 * x + (j >> 3); ft = 8 * r + (j & 7);
            gemm_issue<4, 2>(W + (size_t)ft * 128 * 1024, 1024, p.xb + (size_t)tt * 256 * 1024, 1024, wreg, treg);
        }
        const int slot = (cft >= 6 && cft < 14) ? cft - 6 : -1;
        epi_inproj<4>(p, acc, ctt * 256, cft * 128, slot, lds);
    }
    for (int mi = blockIdx.x; mi < 64; mi += gridDim.x) {
        f32x16 acc[1][2]; zero_acc(acc);
        gemm_tile<1, 2>(W + (size_t)3072 * 1024, 1024, p.xb + (size_t)mi * 256 * 1024, 1024, 1024, lds, acc);
        epi_inproj<1>(p, acc, mi * 256, C_KR, -1, lds);
    }
}

DI void epi_q(const Params& p, int layer, f32x16 (&acc)[3][2], int tok0, int head) {
    __builtin_amdgcn_sched_barrier(0);
    const int lane = otid() & 63, wave = otid() >> 6, l31 = lane & 31, hh = lane >> 5;
    const float* g = p.qk_q_g + layer * 96;
    const float QS = 0.10206207261596577f * 1.4426950408889634f;
#pragma unroll
    for (int tb = 0; tb < 2; ++tb) {
        const int t = tok0 + wave * 64 + tb * 32 + l31, pos = t & (SEQ - 1), bidx = t >> 13;
        const float* sp = p.ss_p + t * 8;
        const float rc = rsqrtf(((sp[0] + sp[1]) + (sp[2] + sp[3]) + (sp[4] + sp[5])) * (1.0f / 768.0f) + EPS);
        float ss = 0.f;
#pragma unroll
        for (int fb = 0; fb < 3; ++fb)
#pragma unroll
            for (int r = 0; r < 16; ++r) ss += acc[fb][tb][r] * acc[fb][tb][r];
        ss += __shfl_xor(ss, 32);
        const float rn = rc * rsqrtf(ss * rc * rc * (1.0f / 96.0f) + EPS);
        bf16_t* dst = p.Q + ((size_t)(bidx * 8 + head) * SEQ + pos) * 96 + 4 * hh;
#pragma unroll
        for (int fb = 0; fb < 2; ++fb)
#pragma unroll
            for (int gq = 0; gq < 4; ++gq) {
                const f32x4 gv = *(const f32x4*)(g + 32 * fb + 8 * gq + 4 * hh);
                const float s = rn * QS;
                u32x2 w; w.x = pk(acc[fb][tb][4 * gq] * s * gv.x, acc[fb][tb][4 * gq + 1] * s * gv.y);
                w.y = pk(acc[fb][tb][4 * gq + 2] * s * gv.z, acc[fb][tb][4 * gq + 3] * s * gv.w);
                *(u32x2*)(dst + 32 * fb + 8 * gq) = w;
            }
        const float* rp = p.rope + pos * 32;
#pragma unroll
        for (int gq = 0; gq < 2; ++gq) {
            const int i0 = 8 * gq + 4 * hh;
            const f32x4 c4 = *(const f32x4*)(rp + i0), s4 = *(const f32x4*)(rp + 16 + i0);
            const f32x4 g1 = *(const f32x4*)(g + 64 + i0), g2 = *(const f32x4*)(g + 80 + i0);
            float o1[4], o2[4];
#pragma unroll
            for (int i = 0; i < 4; ++i) {
                const float x1 = acc[2][tb][4 * gq + i] * rn * g1[i] * QS, x2 = acc[2][tb][4 * gq + i + 8] * rn * g2[i] * QS;
                o1[i] = x1 * c4[i] - x2 * s4[i]; o2[i] = x1 * s4[i] + x2 * c4[i];
            }
            u32x2 w1, w2; w1.x = pk(o1[0], o1[1]); w1.y = pk(o1[2], o1[3]); w2.x = pk(o2[0], o2[1]); w2.y = pk(o2[2], o2[3]);
            *(u32x2*)(dst + 64 + 8 * gq) = w1;
            *(u32x2*)(dst + 80 + 8 * gq) = w2;
        }
    }
}

DI void epi_kv(const Params& p, int layer, f32x16 (&acc)[4][2], int tok0, int head) {
    __builtin_amdgcn_sched_barrier(0);
    const int lane = otid() & 63, wave = otid() >> 6, l31 = lane & 31, hh = lane >> 5;
    const float* g = p.qk_k_g + layer * 96;
#pragma unroll
    for (int tb = 0; tb < 2; ++tb) {
        const int t = tok0 + wave * 64 + tb * 32 + l31, pos = t & (SEQ - 1), bidx = t >> 13;
        const float rc = rsqrtf((p.ss_p[t * 8 + 6] + p.ss_p[t * 8 + 7]) * (1.0f / 256.0f) + EPS);
        const int pp = (pos & ~15) | ((pos & 4) << 1) | ((pos & 8) >> 1) | (pos & 3);
        char* vbase = (char*)(p.VT + (size_t)((tok0 >> 13) * 8 + head) * 64 * SEQ);
        const unsigned voff = (unsigned)(4 * hh * SEQ + pp) * 2u;
#pragma unroll
        for (int fb = 2; fb < 4; ++fb)
#pragma unroll
            for (int r = 0; r < 16; ++r) {
                const int dvc = 32 * (fb - 2) + (r & 3) + 8 * (r >> 2);
                *(bf16_t*)(vbase + (size_t)dvc * SEQ * 2 + voff) = (bf16_t)(pk(acc[fb][tb][r] * rc, 0.f) & 0xffffu);
            }
        asm volatile("" ::: "memory");
        const bf16_t* kr = p.proj + (size_t)t * NIN + C_KR + 8 * hh;
        const u32x4 ka = *(const u32x4*)kr, kb = *(const u32x4*)(kr + 16);
        float x1[8], x2[8];
#pragma unroll
        for (int i = 0; i < 4; ++i) { x1[2 * i] = bflo(ka[i]); x1[2 * i + 1] = bfhi(ka[i]); x2[2 * i] = bflo(kb[i]); x2[2 * i + 1] = bfhi(kb[i]); }
        float ss = 0.f, sr = 0.f;
#pragma unroll
        for (int i = 0; i < 8; ++i) sr += x1[i] * x1[i] + x2[i] * x2[i];
#pragma unroll
        for (int fb = 0; fb < 2; ++fb)
#pragma unroll
            for (int r = 0; r < 16; ++r) ss += acc[fb][tb][r] * acc[fb][tb][r];
        ss = ss * rc * rc + sr;
        ss += __shfl_xor(ss, 32);
        const float rn = rsqrtf(ss * (1.0f / 96.0f) + EPS);
        const float rk = rn * rc;
        bf16_t* kd = p.K + ((size_t)(bidx * 8 + head) * SEQ + pos) * 96;
#pragma unroll
        for (int fb = 0; fb < 2; ++fb)
#pragma unroll
            for (int gq = 0; gq < 4; ++gq) {
                const int f = 32 * fb + 8 * gq + 4 * hh;
                const f32x4 gv = *(const f32x4*)(g + f);
                u32x2 w; w.x = pk(acc[fb][tb][4 * gq] * rk * gv.x, acc[fb][tb][4 * gq + 1] * rk * gv.y);
                w.y = pk(acc[fb][tb][4 * gq + 2] * rk * gv.z, acc[fb][tb][4 * gq + 3] * rk * gv.w);
                *(u32x2*)(kd + f) = w;
            }
        {
            const float* rp = p.rope + pos * 32 + 8 * hh;
            float o1[8], o2[8];
#pragma unroll
            for (int q4 = 0; q4 < 2; ++q4) {
                const f32x4 c4 = *(const f32x4*)(rp + 4 * q4), s4 = *(const f32x4*)(rp + 16 + 4 * q4);
                const f32x4 g1 = *(const f32x4*)(g + 64 + 8 * hh + 4 * q4), g2 = *(const f32x4*)(g + 80 + 8 * hh + 4 * q4);
#pragma unroll
                for (int i = 0; i < 4; ++i) {
                    const float a = x1[4 * q4 + i] * rn * g1[i], b = x2[4 * q4 + i] * rn * g2[i];
                    o1[4 * q4 + i] = a * c4[i] - b * s4[i]; o2[4 * q4 + i] = a * s4[i] + b * c4[i];
                }
            }
            u32x4 w1, w2;
            w1.x = pk(o1[0], o1[1]); w1.y = pk(o1[2], o1[3]); w1.z = pk(o1[4], o1[5]); w1.w = pk(o1[6], o1[7]);
            w2.x = pk(o2[0], o2[1]); w2.y = pk(o2[2], o2[3]); w2.z = pk(o2[4], o2[5]); w2.w = pk(o2[6], o2[7]);
            *(u32x4*)(kd + 64 + 8 * hh) = w1;
            *(u32x4*)(kd + 80 + 8 * hh) = w2;
        }
    }
}

DI void conv_item(const Params& p, int layer, int ct, char* lds) {
    const int tid = otid(), lane = tid & 63, wave = tid >> 6, l31 = lane & 31, hh = lane >> 5;
    constexpr int CR = 528;
    const int t0 = ct * 64, pos0 = t0 & (SEQ - 1);
    __syncthreads();
#pragma unroll 1
    for (int c0 = tid; c0 < 94 * 32; c0 += 1024) {
        u32x4 a[4], g[4];
#pragma unroll
        for (int u = 0; u < 4; ++u) {
            const int c = c0 + 256 * u, i = c >> 5, ch = c & 31;
            a[u] = (u32x4){0u, 0u, 0u, 0u}; g[u] = a[u];
            if (c < 94 * 32 && pos0 - 30 + i >= 0) {
                const bf16_t* src = p.proj + (size_t)(t0 - 30 + i) * NIN + 8 * ch;
                a[u] = *(const u32x4*)(src + C_A); g[u] = *(const u32x4*)(src + C_AG);
            }
        }
#pragma unroll
        for (int u = 0; u < 4; ++u) {
            const int c = c0 + 256 * u, i = c >> 5, ch = c & 31;
            if (c < 94 * 32) {
                u32x4 w;
#pragma unroll
                for (int e = 0; e < 4; ++e) w[e] = pk(bflo(a[u][e]) * sigmoidf_(bflo(g[u][e])), bfhi(a[u][e]) * sigmoidf_(bfhi(g[u][e])));
                *(u32x4*)(lds + i * CR + ch * 16) = w;
            }
        }
    }
    __syncthreads();
    {
        float w[31];
        const char* cw = (const char*)(p.conv_w + (size_t)layer * 31 * 256);
        const unsigned cwo = (unsigned)tid * 4u;
#pragma unroll
        for (int k = 0; k < 31; ++k) w[k] = *(const float*)(cw + k * 1024 + cwo);
        const float cb = p.conv_b[layer * 256 + tid];
#pragma unroll 1
        for (int tg = 0; tg < 8; ++tg) {
            float in[38];
            const char* base = lds + (8 * tg) * CR + 2 * tid;
#pragma unroll
            for (int i = 0; i < 38; ++i) in[i] = __uint_as_float((unsigned)(*(const bf16_t*)(base + i * CR)) << 16);
#pragma unroll
            for (int j = 0; j < 8; ++j) {
                float o = cb;
#pragma unroll
                for (int k = 0; k < 31; ++k) o += w[k] * in[j + k];
                *(bf16_t*)(lds + (8 * tg + j) * CR + 2 * tid) = (bf16_t)(pk(o, 0.f) & 0xffffu);
            }
        }
    }
    __syncthreads();
    {
        const int tok = tid >> 2, part = tid & 3;
        char* base = lds + tok * CR + part * 128;
        float v[64];
#pragma unroll
        for (int i = 0; i < 8; ++i) {
            const u32x4 w = *(const u32x4*)(base + 16 * i);
#pragma unroll
            for (int e = 0; e < 4; ++e) { v[8 * i + 2 * e] = bflo(w[e]); v[8 * i + 2 * e + 1] = bfhi(w[e]); }
        }
        float s = 0.f;
#pragma unroll
        for (int i = 0; i < 64; ++i) s += v[i];
        s += __shfl_xor(s, 1); s += __shfl_xor(s, 2);
        const float mu = s * (1.0f / 256.0f);
        float q = 0.f;
#pragma unroll
        for (int i = 0; i < 64; ++i) { const float d = v[i] - mu; q += d * d; }
        q += __shfl_xor(q, 1); q += __shfl_xor(q, 2);
        const float rs = rsqrtf(q * (1.0f / 256.0f) + EPS);
        const float* lg = p.conv_ln_g + layer * 256 + part * 64;
        const float* lb = p.conv_ln_b + layer * 256 + part * 64;
#pragma unroll
        for (int i = 0; i < 8; ++i) {
            const f32x4 g0 = *(const f32x4*)(lg + 8 * i), g1 = *(const f32x4*)(lg + 8 * i + 4);
            const f32x4 b0 = *(const f32x4*)(lb + 8 * i), b1 = *(const f32x4*)(lb + 8 * i + 4);
            float y[8];
#pragma unroll
            for (int e = 0; e < 4; ++e) { y[e] = siluf_((v[8 * i + e] - mu) * rs * g0[e] + b0[e]); y[4 + e] = siluf_((v[8 * i + 4 + e] - mu) * rs * g1[e] + b1[e]); }
            u32x4 w; w.x = pk(y[0], y[1]); w.y = pk(y[2], y[3]); w.z = pk(y[4], y[5]); w.w = pk(y[6], y[7]);
            *(u32x4*)(base + 16 * i) = w;
        }
    }
    __syncthreads();
    f32x16 acc[2][2]; zero_acc(acc);
    {
        const bf16_t* wsrc = p.PwT + (size_t)layer * 256 * 256 + (size_t)(64 * wave + l31) * 256 + 8 * hh;
        const char* tfp = lds + l31 * CR + hh * 16;
#pragma unroll 8
        for (int s = 0; s < 16; ++s) {
            bf16x8 wf[2], tf[2];
#pragma unroll
            for (int fb = 0; fb < 2; ++fb) wf[fb] = *(const bf16x8*)(wsrc + fb * 32 * 256 + 16 * s);
#pragma unroll
            for (int tb = 0; tb < 2; ++tb) tf[tb] = *(const bf16x8*)(tfp + tb * 32 * CR + s * 32);
#pragma unroll
            for (int fb = 0; fb < 2; ++fb)
#pragma unroll
                for (int tb = 0; tb < 2; ++tb) acc[fb][tb] = mfma(wf[fb], tf[tb], acc[fb][tb]);
        }
    }
    float* red = (float*)(lds + 49664);
    float ss[2] = {0.f, 0.f};
#pragma unroll
    for (int tb = 0; tb < 2; ++tb) {
        const int t = t0 + 32 * tb + l31;
#pragma unroll
        for (int fb = 0; fb < 2; ++fb)
#pragma unroll
            for (int gq = 0; gq < 4; ++gq) {
                const int f = 64 * wave + 32 * fb + 8 * gq + 4 * hh;
                const f32x4 bv = *(const f32x4*)(p.conv_pw_b + layer * 256 + f);
                const u32x2 z = *(const u32x2*)(p.proj + (size_t)t * NIN + C_ZC + f);
                const float v0 = (acc[fb][tb][4 * gq] + bv.x) * siluf_(bflo(z.x)), v1 = (acc[fb][tb][4 * gq + 1] + bv.y) * siluf_(bfhi(z.x));
                const float v2 = (acc[fb][tb][4 * gq + 2] + bv.z) * siluf_(bflo(z.y)), v3 = (acc[fb][tb][4 * gq + 3] + bv.w) * siluf_(bfhi(z.y));
                acc[fb][tb][4 * gq] = v0; acc[fb][tb][4 * gq + 1] = v1; acc[fb][tb][4 * gq + 2] = v2; acc[fb][tb][4 * gq + 3] = v3;
                ss[tb] += v0 * v0 + v1 * v1 + v2 * v2 + v3 * v3;
            }
        ss[tb] += __shfl_xor(ss[tb], 32);
        if (hh == 0) red[wave * 64 + 32 * tb + l31] = ss[tb];
    }
    __syncthreads();
#pragma unroll
    for (int tb = 0; tb < 2; ++tb) {
        const int t = t0 + 32 * tb + l31, ti = 32 * tb + l31;
        const float tot = (red[ti] + red[64 + ti]) + (red[128 + ti] + red[192 + ti]);
        const float rn = rsqrtf(tot * (1.0f / 256.0f) + EPS);
#pragma unroll
        for (int fb = 0; fb < 2; ++fb)
#pragma unroll
            for (int gq = 0; gq < 4; ++gq) {
                const int f = 64 * wave + 32 * fb + 8 * gq + 4 * hh;
                u32x2 w; w.x = pk(acc[fb][tb][4 * gq] * rn, acc[fb][tb][4 * gq + 1] * rn); w.y = pk(acc[fb][tb][4 * gq + 2] * rn, acc[fb][tb][4 * gq + 3] * rn);
                *(u32x2*)(p.Y + (size_t)t * 1024 + 768 + f) = w;
            }
    }
}

DI void sgu_item(const Params& p, int layer, int ch, char* lds) {
    const int tid = otid(), lane = tid & 63, wave = tid >> 6, l31 = lane & 31, hh = lane >> 5;
    constexpr int VR = 272;
    const int t0 = ch * 128;
    __syncthreads();
#pragma unroll 1
    for (int hf = 0; hf < 2; ++hf) {
        const int tok = 64 * hf + (tid >> 2), part = tid & 3;
        const bf16_t* src = p.proj + (size_t)(t0 + tok) * NIN + C_V;
        float v[64];
#pragma unroll
        for (int i = 0; i < 8; ++i) {
            const u32x4 w = *(const u32x4*)(src + 8 * (4 * i + part));
#pragma unroll
            for (int e = 0; e < 4; ++e) { v[8 * i + 2 * e] = geluf_(bflo(w[e])); v[8 * i + 2 * e + 1] = geluf_(bfhi(w[e])); }
        }
        float s = 0.f;
#pragma unroll
        for (int i = 0; i < 64; ++i) s += v[i];
        s += __shfl_xor(s, 1); s += __shfl_xor(s, 2);
        const float mu = s * (1.0f / 256.0f);
        float q = 0.f;
#pragma unroll
        for (int i = 0; i < 64; ++i) { const float d = v[i] - mu; q += d * d; }
        q += __shfl_xor(q, 1); q += __shfl_xor(q, 2);
        const float rs = rsqrtf(q * (1.0f / 256.0f) + EPS);
#pragma unroll
        for (int i = 0; i < 8; ++i) {
            const int c0 = 8 * (4 * i + part);
            const float* lg = p.sg_ln_g + layer * 256 + c0;
            const float* lb = p.sg_ln_b + layer * 256 + c0;
            const f32x4 g0 = *(const f32x4*)lg, g1 = *(const f32x4*)(lg + 4), b0 = *(const f32x4*)lb, b1 = *(const f32x4*)(lb + 4);
#pragma unroll
            for (int e = 0; e < 4; ++e) {
                const float y0 = (v[8 * i + e] - mu) * rs * g0[e] + b0[e], y1 = (v[8 * i + 4 + e] - mu) * rs * g1[e] + b1[e];
                *(bf16_t*)(lds + (c0 + e) * VR + tok * 2) = (bf16_t)(pk(y0, 0.f) & 0xffffu);
                *(bf16_t*)(lds + (c0 + 4 + e) * VR + tok * 2) = (bf16_t)(pk(y1, 0.f) & 0xffffu);
            }
        }
    }
    __syncthreads();
    const int tch = 32 * wave + l31, t = t0 + tch;
    float ss = 0.f;
#pragma unroll 1
    for (int hp = 0; hp < 2; ++hp) {
        f32x16 acc[4][1]; zero_acc(acc);
        const bf16_t* wsrc = p.SgW + ((size_t)(layer * 4 + 2 * hp) * 128 + 32 * wave + l31) * 128 + 8 * hh;
        const char* afp = lds + (128 * hp + l31) * VR + hh * 16;
        const int nsteps = 2 * (wave + 1);
        bf16x8 bfr[2][8];
#pragma unroll
        for (int s = 0; s < 8; ++s)
#pragma unroll
            for (int g = 0; g < 2; ++g) bfr[g][s] = (s < nsteps) ? *(const bf16x8*)(wsrc + (size_t)g * 128 * 128 + 16 * s) : (bf16x8){0, 0, 0, 0, 0, 0, 0, 0};
#pragma unroll
        for (int s = 0; s < 8; ++s) {
            if (s < nsteps) {
#pragma unroll
                for (int g = 0; g < 2; ++g)
#pragma unroll
                    for (int e = 0; e < 2; ++e) {
                        const int fb = 2 * g + e;
                        const bf16x8 afr = *(const bf16x8*)(afp + fb * 32 * VR + s * 32);
                        acc[fb][0] = mfma(afr, bfr[g][s], acc[fb][0]);
                    }
            }
        }
#pragma unroll
        for (int fb = 0; fb < 4; ++fb) {
            const float bias = p.sg_b[(layer * 4 + 2 * hp + (fb >> 1)) * 128 + tch];
#pragma unroll
            for (int gq = 0; gq < 4; ++gq) {
                const int f = 128 * hp + 32 * fb + 8 * gq + 4 * hh;
                const u32x2 u = *(const u32x2*)(p.proj + (size_t)t * NIN + C_U + f);
                const u32x2 z = *(const u32x2*)(p.proj + (size_t)t * NIN + C_ZS + f);
                const float v0 = geluf_(bflo(u.x)) * (acc[fb][0][4 * gq] + bias) * siluf_(bflo(z.x));
                const float v1 = geluf_(bfhi(u.x)) * (acc[fb][0][4 * gq + 1] + bias) * siluf_(bfhi(z.x));
                const float v2 = geluf_(bflo(u.y)) * (acc[fb][0][4 * gq + 2] + bias) * siluf_(bflo(z.y));
                const float v3 = geluf_(bfhi(u.y)) * (acc[fb][0][4 * gq + 3] + bias) * siluf_(bfhi(z.y));
                ss += v0 * v0 + v1 * v1 + v2 * v2 + v3 * v3;
                u32x2 w; w.x = pk(v0, v1); w.y = pk(v2, v3);
                *(u32x2*)(p.Y + (size_t)t * 1024 + 512 + f) = w;
            }
        }
    }
    (void)ss;
}

DI void phase_pre(const Params& p, int layer, char* lds) {
    for (int item = blockIdx.x; item < 512; item += gridDim.x) {
        const int x = item & 7, j = item >> 3, tt = 8 * x + (j >> 3), head = j & 7;
        const bf16_t* Wkv = p.WukvT + (size_t)layer * 1024 * 256 + (size_t)head * 128 * 256;
        const bf16_t* Tkv = p.proj + (size_t)tt * 256 * NIN + C_CKV;
        u32x4 wreg[4], treg[8];
        {
            f32x16 acc[3][2]; zero_acc(acc);
            gemm_tile<3, 2>(p.WuqT + (size_t)layer * 768 * 768 + (size_t)head * 96 * 768, 768, p.proj + (size_t)tt * 256 * NIN + C_CQ, NIN, 768, lds, acc);
            gemm_issue_t<2>(Tkv, NIN, treg);
            epi_q(p, layer, acc, tt * 256, head);
        }
        gemm_issue_w<4>(Wkv, 256, wreg);
        {
            f32x16 acc[4][2]; zero_acc(acc);
            gemm_run<4, 2>(Wkv, 256, Tkv, NIN, 256, lds, acc, wreg, treg);
            epi_kv(p, layer, acc, tt * 256, head);
        }
    }
}

template <bool FIXED>
DI void attn_qtile(const Params& p, int bh, int qt, char* lds) {
    const int tid = otid(), lane = tid & 63, wave = tid >> 6, l31 = lane & 31, hh = lane >> 5;
    constexpr int KR = 208, KB = 64 * KR, VB = 64 * LROW, VOFF = 2 * KB;
    const int q0w = qt * 128 + 32 * wave;
    const bf16_t* Kg = p.K + (size_t)bh * SEQ * 96;
    const bf16_t* Vg = p.VT + (size_t)bh * 64 * SEQ;
    bf16x8 qf[6];
    {
        const bf16_t* qp = p.Q + ((size_t)bh * SEQ + q0w + l31) * 96 + 8 * hh;
#pragma unroll
        for (int s = 0; s < 6; ++s) qf[s] = *(const bf16x8*)(qp + 16 * s);
    }
    f32x16 O[2];
#pragma unroll
    for (int d = 0; d < 2; ++d)
#pragma unroll
        for (int r = 0; r < 16; ++r) O[d][r] = 0.f;
    float m = -1e30f, l = 0.f;
    const int ntiles = 2 * qt + 2;
    u32x4 kreg[3], vreg[2];
    const int vdv = tid >> 3, vkc = tid & 7;
#define ATT_GLOAD(j) { \
        _Pragma("unroll") for (int i = 0; i < 3; ++i) kreg[i] = *(const u32x4*)(Kg + (size_t)(j) * 64 * 96 + (tid + 256 * i) * 8); \
        _Pragma("unroll") for (int i = 0; i < 2; ++i) vreg[i] = *(const u32x4*)(Vg + (size_t)(vdv + 32 * i) * SEQ + (j) * 64 + vkc * 8); }
#define ATT_LSTORE(buf) { \
        _Pragma("unroll") for (int i = 0; i < 3; ++i) { const int c = tid + 256 * i; *(u32x4*)(lds + (buf) * KB + (c / 12) * KR + (c % 12) * 16) = kreg[i]; } \
        _Pragma("unroll") for (int i = 0; i < 2; ++i) *(u32x4*)(lds + VOFF + (buf) * VB + (vdv + 32 * i) * LROW + vkc * 16) = vreg[i]; }
    __syncthreads();
    ATT_GLOAD(0);
    ATT_LSTORE(0);
    if (ntiles > 1) ATT_GLOAD(1);
    __syncthreads();
    for (int j = 0; j < ntiles; ++j) {
        const int kv0 = 64 * j;
        if (kv0 <= q0w + 31) {
            const char* Kb = lds + (j & 1) * KB + l31 * KR + hh * 16;
            const char* Vb = lds + VOFF + (j & 1) * VB + l31 * LROW + hh * 16;
            f32x16 sc[2];
            bf16x8 kf[2][6], vf[2][4];
#pragma unroll
            for (int kb = 0; kb < 2; ++kb)
#pragma unroll
                for (int s = 0; s < 6; ++s) kf[kb][s] = *(const bf16x8*)(Kb + kb * 32 * KR + s * 32);
            __builtin_amdgcn_sched_barrier(0);
#pragma unroll
            for (int kb = 0; kb < 2; ++kb)
#pragma unroll
                for (int r = 0; r < 16; ++r) sc[kb][r] = 0.f;
#pragma unroll
            for (int s = 0; s < 6; ++s)
#pragma unroll
                for (int kb = 0; kb < 2; ++kb) sc[kb] = mfma(kf[kb][s], qf[s], sc[kb]);
#pragma unroll
            for (int d = 0; d < 2; ++d)
#pragma unroll
                for (int ks = 0; ks < 4; ++ks) vf[d][ks] = *(const bf16x8*)(Vb + d * 32 * LROW + ks * 32);
            __builtin_amdgcn_sched_barrier(0);
            if (kv0 + 63 > q0w) {
                const int qi = q0w + l31;
#pragma unroll
                for (int kb = 0; kb < 2; ++kb)
#pragma unroll
                    for (int r = 0; r < 16; ++r) { const int key = kv0 + 32 * kb + crow(r, hh); if (key > qi) sc[kb][r] = -1e30f; }
            }
            if (FIXED) {
                f32x2 rs2 = {0.f, 0.f};
#pragma unroll
                for (int kb = 0; kb < 2; ++kb)
#pragma unroll
                    for (int r = 0; r < 16; r += 2) { const float p0 = fexp2(sc[kb][r]), p1 = fexp2(sc[kb][r + 1]); sc[kb][r] = p0; sc[kb][r + 1] = p1; rs2 += (f32x2){p0, p1}; }
                l += rs2.x + rs2.y;
            } else {
            float mx = -1e30f;
#pragma unroll
            for (int kb = 0; kb < 2; ++kb)
#pragma unroll
                for (int r = 0; r < 16; ++r) mx = fmaxf(mx, sc[kb][r]);
            mx = fmaxf(mx, __shfl_xor(mx, 32));
            const float mn = fmaxf(m, mx), alpha = fexp2(m - mn);
            m = mn;
            float rsum = 0.f;
#pragma unroll
            for (int kb = 0; kb < 2; ++kb)
#pragma unroll
                for (int r = 0; r < 16; ++r) { const float pv = fexp2(sc[kb][r] - mn); sc[kb][r] = pv; rsum += pv; }
            l = l * alpha + rsum;
#pragma unroll
            for (int d = 0; d < 2; ++d)
#pragma unroll
                for (int r = 0; r < 16; ++r) O[d][r] *= alpha;
            }
#pragma unroll
            for (int kb = 0; kb < 2; ++kb)
#pragma unroll
                for (int sp = 0; sp < 2; ++sp) {
                    u32x4 w;
                    w.x = pk(sc[kb][8 * sp], sc[kb][8 * sp + 1]); w.y = pk(sc[kb][8 * sp + 2], sc[kb][8 * sp + 3]);
                    w.z = pk(sc[kb][8 * sp + 4], sc[kb][8 * sp + 5]); w.w = pk(sc[kb][8 * sp + 6], sc[kb][8 * sp + 7]);
                    const bf16x8 pf = __builtin_bit_cast(bf16x8, w);
#pragma unroll
                    for (int d = 0; d < 2; ++d) O[d] = mfma(vf[d][2 * kb + sp], pf, O[d]);
                }
        }
        if (j + 1 < ntiles) {
            ATT_LSTORE((j + 1) & 1);
            if (j + 2 < ntiles) ATT_GLOAD(j + 2);
        }
        __syncthreads();
    }
#undef ATT_GLOAD
#undef ATT_LSTORE
    l += __shfl_xor(l, 32);
    const float inv = 1.0f / l;
    const int head = bh & 7, bidx = bh >> 3;
    const int t = bidx * SEQ + q0w + l31;
    float ss = 0.f;
#pragma unroll
    for (int d = 0; d < 2; ++d)
#pragma unroll
        for (int gq = 0; gq < 4; ++gq) {
            const int dv = 32 * d + 8 * gq + 4 * hh;
            const u32x2 z = *(const u32x2*)(p.proj + (size_t)t * NIN + C_ZM + head * 64 + dv);
            const float v0 = O[d][4 * gq] * inv * siluf_(bflo(z.x)), v1 = O[d][4 * gq + 1] * inv * siluf_(bfhi(z.x));
            const float v2 = O[d][4 * gq + 2] * inv * siluf_(bflo(z.y)), v3 = O[d][4 * gq + 3] * inv * siluf_(bfhi(z.y));
            ss += v0 * v0 + v1 * v1 + v2 * v2 + v3 * v3;
            u32x2 w; w.x = pk(v0, v1); w.y = pk(v2, v3);
            *(u32x2*)(p.Y + (size_t)t * 1024 + head * 64 + dv) = w;
        }
    (void)ss;
}

DI void phase_attn(const Params& p, int layer, char* lds) {
    float gq = 0.f, gk = 0.f;
    for (int i = 0; i < 96; ++i) { gq = fmaxf(gq, fabsf(p.qk_q_g[layer * 96 + i])); gk = fmaxf(gk, fabsf(p.qk_k_g[layer * 96 + i])); }
    const bool fixed_ok = 96.0f * gq * gk * (0.10206207261596577f * 1.4426950408889634f) < 40.0f;
    for (int item = blockIdx.x; item < 256; item += gridDim.x) conv_item(p, layer, item, lds);
    for (int item = blockIdx.x; item < 512; item += gridDim.x) {
        const int bh = 2 * (item & 7) + (item >> 8), i = (item >> 3) & 31;
        if (fixed_ok) { attn_qtile<true>(p, bh, 63 - i, lds); attn_qtile<true>(p, bh, i, lds); }
        else { attn_qtile<false>(p, bh, 63 - i, lds); attn_qtile<false>(p, bh, i, lds); }
    }
    for (int item = gridDim.x - 1 - blockIdx.x; item < 128; item += gridDim.x) sgu_item(p, layer, item, lds);
}

DI void phase_norm(const Params& p) {
    const int lane = threadIdx.x & 63, wave = threadIdx.x >> 6;
    for (int t0 = (blockIdx.x * 4 + wave) * 4; t0 < NT; t0 += gridDim.x * 16) {
        u32x4 m[4]; u32x2 g[4];
#pragma unroll
        for (int r = 0; r < 4; ++r) { const bf16_t* row = p.Y + (size_t)(t0 + r) * 1024; m[r] = *(const u32x4*)(row + 8 * lane); g[r] = *(const u32x2*)(row + 512 + 4 * lane); }
        float sm[4], sg[4];
#pragma unroll
        for (int r = 0; r < 4; ++r) {
            sm[r] = 0.f; sg[r] = 0.f;
#pragma unroll
            for (int e = 0; e < 4; ++e) { const float a = bflo(m[r][e]), b = bfhi(m[r][e]); sm[r] += a * a + b * b; }
#pragma unroll
            for (int e = 0; e < 2; ++e) { const float a = bflo(g[r][e]), b = bfhi(g[r][e]); sg[r] += a * a + b * b; }
        }
#pragma unroll
        for (int o = 32; o >= 1; o >>= 1)
#pragma unroll
            for (int r = 0; r < 4; ++r) { sm[r] += __shfl_xor(sm[r], o); sg[r] += __shfl_xor(sg[r], o); }
#pragma unroll
        for (int r = 0; r < 4; ++r) {
            const float rm = rsqrtf(sm[r] * (1.0f / 512.0f) + EPS), rg = rsqrtf(sg[r] * (1.0f / 256.0f) + EPS);
            u32x4 mo; u32x2 go;
#pragma unroll
            for (int e = 0; e < 4; ++e) mo[e] = pk(bflo(m[r][e]) * rm, bfhi(m[r][e]) * rm);
#pragma unroll
            for (int e = 0; e < 2; ++e) go[e] = pk(bflo(g[r][e]) * rg, bfhi(g[r][e]) * rg);
            bf16_t* row = p.Y + (size_t)(t0 + r) * 1024;
            *(u32x4*)(row + 8 * lane) = mo;
            *(u32x2*)(row + 512 + 4 * lane) = go;
        }
    }
}

DI void phase_out(const Params& p, int layer, char* lds) {
    const int lane = otid() & 63, wave = otid() >> 6, l31 = lane & 31, hh = lane >> 5;
    const float* xin = layer == 0 ? p.x : p.out;
    const bf16_t* W = p.WoutT + (size_t)layer * 1024 * 1024;
    for (int item = blockIdx.x; item < 512; item += gridDim.x) {
        const int x = item & 7, j = item >> 3, tt = 8 * x + (j >> 3), ft = j & 7;
        f32x16 acc[4][2]; zero_acc(acc);
        const bf16_t* Wt = W + (size_t)ft * 128 * 1024;
        const bf16_t* Yt = p.Y + (size_t)tt * 256 * 1024;
        gemm_tile<4, 2>(Wt, 1024, Yt, 1024, 1024, lds, acc);
        {
            char* wl = lds + wave * (32 * 528);
            const int c = lane & 31, rh = lane >> 5;
            __syncthreads();
#pragma unroll
            for (int tb = 0; tb < 2; ++tb) {
                const int tw = tt * 256 + wave * 64 + tb * 32;
#pragma unroll
                for (int fb = 0; fb < 4; ++fb)
#pragma unroll
                    for (int gq = 0; gq < 4; ++gq) {
                        f32x4 v; v.x = acc[fb][tb][4 * gq]; v.y = acc[fb][tb][4 * gq + 1]; v.z = acc[fb][tb][4 * gq + 2]; v.w = acc[fb][tb][4 * gq + 3];
                        *(f32x4*)(wl + l31 * 528 + (32 * fb + 8 * gq + 4 * hh) * 4) = v;
                    }
#pragma unroll 4
                for (int i = 0; i < 16; ++i) {
                    const int row = 2 * i + rh, t = tw + row, f = ft * 128 + 4 * c;
                    const f32x4 v = *(const f32x4*)(wl + row * 528 + c * 16);
                    f32x4 xv = *(const f32x4*)(xin + (size_t)t * 1024 + f);
                    xv.x += v.x; xv.y += v.y; xv.z += v.z; xv.w += v.w;
                    *(f32x4*)(p.out + (size_t)t * 1024 + f) = xv;
                    if (layer == 0) {
                        u32x2 w; w.x = pk(xv.x, xv.y); w.y = pk(xv.z, xv.w);
                        *(u32x2*)(p.xb + (size_t)t * 1024 + f) = w;
                        float ss = xv.x * xv.x + xv.y * xv.y + xv.z * xv.z + xv.w * xv.w;
                        ss += __shfl_xor(ss, 16); ss += __shfl_xor(ss, 8); ss += __shfl_xor(ss, 4); ss += __shfl_xor(ss, 2); ss += __shfl_xor(ss, 1);
                        if (c == 0) p.ss_x[t * 8 + ft] = ss;
                    }
                }
            }
        }
    }
}


#define XB_TMO      128
#define XB_XCNT(j)  (256  + 64 * (j))
#define XB_XSUB(j)  (1280 + 64 * (j))
#define XB_XGEN(j)  (2304 + 64 * (j))
#define XB_TOP      3328
#define XB_TOPGEN   3392
#define XCD_BAR_WORDS 3456
#define XB_SPIN_CAP (1u << 20)
#define LAS __attribute__((address_space(3)))
DI unsigned xb_ld(unsigned* p)              { return __hip_atomic_load(p, __ATOMIC_RELAXED, __HIP_MEMORY_SCOPE_AGENT); }
DI unsigned xb_add(unsigned* p, unsigned v) { return __hip_atomic_fetch_add(p, v, __ATOMIC_RELAXED, __HIP_MEMORY_SCOPE_AGENT); }
DI unsigned xb_xcc_id() { return (unsigned)__builtin_amdgcn_s_getreg((3 << 11) | 20) & 0xFu; }
#define XB_SPIN(cond, bar) do { unsigned _sp = 0; while (cond) { __builtin_amdgcn_s_sleep(1); \
    if ((++_sp & 255u) == 0u) { if (xb_ld(&(bar)[XB_TMO])) break; if (_sp > XB_SPIN_CAP) { atomicAdd(&(bar)[XB_TMO], 1u); break; } } } } while (0)
struct XcdBarrier { unsigned* bar; unsigned x; volatile LAS unsigned* st; };
DI XcdBarrier xcd_barrier_post(unsigned* bar, volatile LAS unsigned* st) {
    XcdBarrier b; b.bar = bar; b.x = xb_xcc_id(); b.st = st;
    if (threadIdx.x == 0) (void)xb_add(&bar[XB_XCNT(b.x)], 1u);
    return b;
}
DI void xcd_barrier_complete(unsigned* bar, unsigned x, unsigned& nloc, unsigned& nx) {
    const unsigned G = gridDim.x * gridDim.y * gridDim.z;
    unsigned sum, cnt, mine, sp = 0u;
    for (;;) {
        sum = 0u; cnt = 0u; mine = 0u;
#pragma unroll
        for (unsigned j = 0; j < 16; ++j) { const unsigned c = xb_ld(&bar[XB_XCNT(j)]); sum += c; cnt += (c > 0u) ? 1u : 0u; mine = (j == x) ? c : mine; }
        if (sum == G) break;
        __builtin_amdgcn_s_sleep(1);
        if ((++sp & 255u) == 0u) { if (xb_ld(&bar[XB_TMO])) break; if (sp > XB_SPIN_CAP) { atomicAdd(&bar[XB_TMO], 1u); break; } }
    }
    nloc = mine > 0u ? mine : 1u; nx = cnt > 0u ? cnt : 1u;
}
DI void xcd_barrier(const XcdBarrier& b) {
    asm volatile("s_waitcnt vmcnt(0)" ::: "memory");
    __syncthreads();
    if (threadIdx.x == 0) {
        unsigned* bar = b.bar;
        __builtin_amdgcn_s_waitcnt(0);
        unsigned nloc = b.st[0], nx = b.st[1];
        if (nloc == 0u) { xcd_barrier_complete(bar, b.x, nloc, nx); b.st[0] = nloc; b.st[1] = nx; }
        const unsigned old = xb_add(&bar[XB_XSUB(b.x)], 1u);
        const unsigned gen = old / nloc;
        if (old + 1u == (gen + 1u) * nloc) {
            __builtin_amdgcn_fence(__ATOMIC_RELEASE, "agent");
            asm volatile("s_waitcnt vmcnt(0)" ::: "memory");
            const unsigned og = xb_add(&bar[XB_TOP], 1u);
            const unsigned tg = og / nx;
            if (og + 1u == (tg + 1u) * nx) xb_add(&bar[XB_TOPGEN], 1u);
            else XB_SPIN(xb_ld(&bar[XB_TOPGEN]) == tg, bar);
            __builtin_amdgcn_fence(__ATOMIC_ACQUIRE, "agent");
            xb_add(&bar[XB_XGEN(b.x)], 1u);
            asm volatile("s_waitcnt vmcnt(0)" ::: "memory");
        } else {
            XB_SPIN(xb_ld(&bar[XB_XGEN(b.x)]) == gen, bar);
            __builtin_amdgcn_fence(__ATOMIC_ACQUIRE, "agent");
            asm volatile("s_waitcnt vmcnt(0)" ::: "memory");
        }
    }
    __syncthreads();
}
#if MK_LAUNCHES == 1
DI void gsync() {
    asm volatile("s_waitcnt vmcnt(0)" ::: "memory");
    cg::this_grid().sync();
}
__global__ void __launch_bounds__(256, 2) mega_kernel(Params p) {
    __shared__ __attribute__((aligned(16))) char lds[LDS_BYTES];
    __shared__ uint4 xb_words;
    if (threadIdx.x == 0) xb_words = make_uint4(0u, 0u, 0u, 0u);
    __syncthreads();
    for (int i = blockIdx.x * 256 + threadIdx.x; i < XCD_BAR_WORDS + 64; i += gridDim.x * 256) p.bar[i] = 0u;
    gsync();
    if (threadIdx.x == 0) (void)xb_add(&p.bar[XB_XCNT(xb_xcc_id())], 1u);
    phase0(p, lds);
    XcdBarrier xb; xb.bar = p.bar; xb.x = xb_xcc_id(); xb.st = (volatile LAS unsigned*)&xb_words;
    xcd_barrier(xb);
#pragma unroll 1
    for (int layer = 0; layer < 2; ++layer) {
        phase_inproj(p, layer, lds);
        xcd_barrier(xb);
        phase_pre(p, layer, lds);
        xcd_barrier(xb);
        phase_attn(p, layer, lds);
        xcd_barrier(xb);
        phase_norm(p);
        xcd_barrier(xb);
        phase_out(p, layer, lds);
        if (layer == 0) xcd_barrier(xb);
    }
}
#endif

extern "C" void kernel_launch(void* const* d_in, const int* in_sizes, int n_in, void* d_out, int out_size, void* d_ws, size_t ws_size, hipStream_t stream) {
    Params p{};
    p.x = (const float*)d_in[0]; p.norm_g = (const float*)d_in[1]; p.w_in = (const float*)d_in[2]; p.conv_w = (const float*)d_in[3];
    p.conv_b = (const float*)d_in[4]; p.conv_ln_g = (const float*)d_in[5]; p.conv_ln_b = (const float*)d_in[6]; p.conv_pw_w = (const float*)d_in[7];
    p.conv_pw_b = (const float*)d_in[8]; p.q_norm_g = (const float*)d_in[9]; p.w_uq = (const float*)d_in[10]; p.kv_norm_g = (const float*)d_in[11];
    p.w_ukv = (const float*)d_in[12]; p.qk_q_g = (const float*)d_in[13]; p.qk_k_g = (const float*)d_in[14]; p.sg_ln_g = (const float*)d_in[15];
    p.sg_ln_b = (const float*)d_in[16]; p.sg_w = (const float*)d_in[17]; p.sg_b = (const float*)d_in[18]; p.branch_norm_g = (const float*)d_in[19];
    p.w_out = (const float*)d_in[20];
    p.out = (float*)d_out;
    char* ws = (char*)d_ws; size_t off = 0;
    auto take = [&](size_t bytes) { char* r = ws + off; off += (bytes + 255) & ~(size_t)255; return r; };
    p.proj = (bf16_t*)take((size_t)NT * NIN * 2);
    p.xb = (bf16_t*)take((size_t)NT * 1024 * 2);
    p.Q = (bf16_t*)take((size_t)16 * SEQ * 96 * 2);
    p.K = (bf16_t*)take((size_t)16 * SEQ * 96 * 2);
    p.VT = (bf16_t*)take((size_t)16 * 64 * SEQ * 2);
    p.Y = (bf16_t*)take((size_t)NT * 1024 * 2);
    p.WinT = (bf16_t*)take((size_t)2 * 3104 * 1024 * 2);
    p.WuqT = (bf16_t*)take((size_t)2 * 768 * 768 * 2);
    p.WukvT = (bf16_t*)take((size_t)2 * 1024 * 256 * 2);
    p.PwT = (bf16_t*)take((size_t)2 * 256 * 256 * 2);
    p.WoutT = (bf16_t*)take((size_t)2 * 1024 * 1024 * 2);
    p.SgW = (bf16_t*)take((size_t)2 * 4 * 128 * 128 * 2);
    p.ss_x = (float*)take((size_t)NT * 8 * 4);
    p.ss_p = (float*)take((size_t)NT * 8 * 4);
    p.ss_m = (float*)take((size_t)NT * 8 * 4);
    p.ss_s = (float*)take((size_t)NT * 4);
    p.rope = (float*)take((size_t)SEQ * 32 * 4);
    p.bar = (unsigned*)take(16384);
    for (int i = 0; i < 16; ++i) p.invf[i] = powf(10000.0f, -(float)i / 16.0f);
    if (off > ws_size) { fprintf(stderr, "workspace too small: need %zu have %zu\n", off, ws_size); return; }
#if MK_LAUNCHES == 1
    static int grid_blocks = 0;
    if (!grid_blocks) {
        int dev = 0, cus = 0, per_cu = 0;
        hipGetDevice(&dev);
        hipDeviceGetAttribute(&cus, hipDeviceAttributeMultiprocessorCount, dev);
        hipOccupancyMaxActiveBlocksPerMultiprocessor(&per_cu, mega_kernel, 256, 0);
        if (per_cu > 2) per_cu = 2;
        grid_blocks = cus * per_cu;
    }
    void* args[] = {&p};
    hipError_t e = hipLaunchCooperativeKernel((void*)mega_kernel, dim3(grid_blocks), dim3(256), args, 0, stream);
    if (e != hipSuccess) fprintf(stderr, "cooperative launch failed: %s (grid %d)\n", hipGetErrorString(e), grid_blocks);
#endif
}
```
